# Optimizing an MI355X kernel written in HIP

```python
import jax, jax.numpy as jnp
from jax import lax
import numpy as np

D_MODEL = 1024
BATCH = 8
SEQ = 8192
DEPTH = 4

CHUNK = 128
N_MIXERS = 2
N_SGU_LAYERS = (DEPTH + 1) // 2
N_RET_LAYERS = DEPTH // 2
EPS = 1e-6
SGU_WIDTH = D_MODEL
SGU_GROUPS = 8
SGU_GROUP_DIM = SGU_WIDTH // SGU_GROUPS
RET_HEADS = 4
RET_QK_DIM = D_MODEL // RET_HEADS
RET_V_DIM = 2 * D_MODEL // RET_HEADS
RET_QK_WIDTH = RET_HEADS * RET_QK_DIM
RET_V_WIDTH = RET_HEADS * RET_V_DIM
RET_IN_WIDTH = 2 * RET_QK_WIDTH + 2 * RET_V_WIDTH
ROPE_BASE = 10000.0
FFN_HIDDEN = -(-8 * D_MODEL // (3 * 256)) * 256

kernel_name = "hybrid_sgu_retention_trunk"


def rmsnorm(x, g):
    xf = x.astype(jnp.float32)
    y = xf * lax.rsqrt(jnp.mean(xf * xf, axis=-1, keepdims=True) + EPS)
    return (y * g.astype(jnp.float32)).astype(x.dtype)


def layernorm(x, g, b):
    xf = x.astype(jnp.float32)
    mu = jnp.mean(xf, axis=-1, keepdims=True)
    var = jnp.mean(jnp.square(xf - mu), axis=-1, keepdims=True)
    y = (xf - mu) * lax.rsqrt(var + EPS)
    return (y * g.astype(jnp.float32) + b.astype(jnp.float32)).astype(x.dtype)


def sgu_mixer(h, w_in, w_s, b_s, ln_g, ln_b, w_out):
    B, S, _ = h.shape
    nc = S // CHUNK
    z = jax.nn.gelu(h @ w_in)
    u, v = jnp.split(z, 2, axis=-1)
    v = layernorm(v, ln_g, ln_b)
    v = v.reshape(B, nc, CHUNK, SGU_GROUPS, SGU_GROUP_DIM)
    causal = jnp.tril(jnp.ones((CHUNK, CHUNK), dtype=bool))
    w = jnp.where(causal[None], w_s, jnp.zeros_like(w_s))
    mixed = jnp.einsum('gts,bcsgd->bctgd', w, v)
    mixed = mixed + b_s.T[None, None, :, :, None]
    mixed = mixed.reshape(B, S, SGU_WIDTH)
    return (u * mixed) @ w_out


def rotary(x, positions):
    half = x.shape[-1] // 2
    inv = 1.0 / (ROPE_BASE ** (jnp.arange(half, dtype=jnp.float32) / half))
    ang = positions.astype(jnp.float32)[..., None] * inv
    cos = jnp.cos(ang)[:, :, None, :]
    sin = jnp.sin(ang)[:, :, None, :]
    xf = x.astype(jnp.float32)
    x1, x2 = xf[..., :half], xf[..., half:]
    return jnp.concatenate([x1 * cos - x2 * sin, x1 * sin + x2 * cos], axis=-1)


def retention(h, positions, w_in, gn_g, w_out):
    B, S, _ = h.shape
    nc = S // CHUNK
    proj = h @ w_in
    q, k, v, g = jnp.split(proj, [RET_QK_WIDTH, 2 * RET_QK_WIDTH,
                                  2 * RET_QK_WIDTH + RET_V_WIDTH], axis=-1)
    q = rotary(q.reshape(B, S, RET_HEADS, RET_QK_DIM), positions)
    k = rotary(k.reshape(B, S, RET_HEADS, RET_QK_DIM), positions) * (RET_QK_DIM ** -0.5)
    v = v.reshape(B, S, RET_HEADS, RET_V_DIM).astype(jnp.float32)

    def to_chunks(t):
        return t.reshape(B, nc, CHUNK, RET_HEADS, -1).transpose(1, 0, 3, 2, 4)

    log_gamma = jnp.log1p(-(2.0 ** (-5.0 - jnp.arange(RET_HEADS, dtype=jnp.float32))))
    idx = jnp.arange(CHUNK, dtype=jnp.float32)
    diff = idx[:, None] - idx[None, :]
    decay_inner = jnp.where(diff >= 0,
                            jnp.exp(log_gamma[:, None, None] * jnp.maximum(diff, 0.0)),
                            0.0)
    cross_decay = jnp.exp(log_gamma[:, None] * (idx + 1.0))
    state_decay = jnp.exp(log_gamma[:, None] * (CHUNK - 1.0 - idx))
    chunk_decay = jnp.exp(log_gamma * CHUNK)

    def step(state, qkv):
        qc, kc, vc = qkv
        scores = jnp.einsum('bhtd,bhsd->bhts', qc, kc) * decay_inner[None]
        inner = jnp.einsum('bhts,bhsv->bhtv', scores, vc)
        cross = jnp.einsum('bhtd,bhdv->bhtv', qc, state) * cross_decay[None, :, :, None]
        new_state = state * chunk_decay[None, :, None, None] + jnp.einsum(
            'bhsd,bhsv->bhdv', kc * state_decay[None, :, :, None], vc)
        return new_state, inner + cross

    state0 = jnp.zeros((B, RET_HEADS, RET_QK_DIM, RET_V_DIM), jnp.float32)
    _, o = lax.scan(step, state0, (to_chunks(q), to_chunks(k), to_chunks(v)))
    o = o.transpose(1, 0, 3, 2, 4).reshape(B, S, RET_HEADS, RET_V_DIM)
    o = o * lax.rsqrt(jnp.mean(o * o, axis=-1, keepdims=True) + EPS)
    o = o.reshape(B, S, RET_V_WIDTH) * gn_g.astype(jnp.float32)
    return (o.astype(h.dtype) * jax.nn.silu(g)) @ w_out


def swiglu(h, w_gu, w_down):
    a, b = jnp.split(h @ w_gu, 2, axis=-1)
    return (jax.nn.silu(a) * b) @ w_down


def setup_inputs(seed: int = 0) -> dict:
    key = jax.random.key(seed)
    ks = jax.random.split(key, 16)
    f32 = jnp.float32

    def nrm(k, shape, scale):
        return jax.random.normal(k, shape, f32) * scale

    na, nb = N_SGU_LAYERS, N_RET_LAYERS
    x = jax.random.normal(ks[0], (BATCH, SEQ, D_MODEL), f32)
    positions = jnp.broadcast_to(jnp.arange(SEQ, dtype=jnp.int32), (BATCH, SEQ))
    return {
        "x": x,
        "positions": positions,
        "mix_norm_g": 1.0 + nrm(ks[1], (DEPTH, D_MODEL), 0.02),
        "ffn_norm_g": 1.0 + nrm(ks[2], (DEPTH, D_MODEL), 0.02),
        "final_norm_g": 1.0 + nrm(ks[3], (D_MODEL,), 0.02),
        "sgu_w_in": nrm(ks[4], (na, D_MODEL, 2 * SGU_WIDTH), D_MODEL ** -0.5),
        "sgu_w_s": nrm(ks[5], (na, SGU_GROUPS, CHUNK, CHUNK), CHUNK ** -0.5),
        "sgu_b_s": 1.0 + nrm(ks[6], (na, SGU_GROUPS, CHUNK), 0.02),
        "sgu_ln_g": 1.0 + nrm(ks[7], (na, SGU_WIDTH), 0.02),
        "sgu_ln_b": nrm(ks[8], (na, SGU_WIDTH), 0.02),
        "sgu_w_out": nrm(ks[9], (na, SGU_WIDTH, D_MODEL), SGU_WIDTH ** -0.5),
        "ret_w_in": nrm(ks[10], (nb, D_MODEL, RET_IN_WIDTH), D_MODEL ** -0.5),
        "ret_gn_g": 1.0 + nrm(ks[11], (nb, RET_V_WIDTH), 0.02),
        "ret_w_out": nrm(ks[12], (nb, RET_V_WIDTH, D_MODEL), RET_V_WIDTH ** -0.5),
        "ffn_w_gu": nrm(ks[13], (DEPTH, D_MODEL, 2 * FFN_HIDDEN), D_MODEL ** -0.5),
        "ffn_w_down": nrm(ks[14], (DEPTH, FFN_HIDDEN, D_MODEL), FFN_HIDDEN ** -0.5),
    }


def reference(x, positions, mix_norm_g, ffn_norm_g, final_norm_g,
              sgu_w_in, sgu_w_s, sgu_b_s, sgu_ln_g, sgu_ln_b, sgu_w_out,
              ret_w_in, ret_gn_g, ret_w_out, ffn_w_gu, ffn_w_down):
    h = x
    for i in range(DEPTH):
        hn = rmsnorm(h, mix_norm_g[i])
        j = i // N_MIXERS
        if i % N_MIXERS == 0:
            h = h + sgu_mixer(hn, sgu_w_in[j], sgu_w_s[j], sgu_b_s[j],
                              sgu_ln_g[j], sgu_ln_b[j], sgu_w_out[j])
        else:
            h = h + retention(hn, positions, ret_w_in[j], ret_gn_g[j], ret_w_out[j])
        h = h + swiglu(rmsnorm(h, ffn_norm_g[i]), ffn_w_gu[i], ffn_w_down[i])
    return rmsnorm(h, final_norm_g)
```

```cpp
#include <hip/hip_runtime.h>
#include <hip/hip_cooperative_groups.h>
#include <cstdio>
namespace cg = cooperative_groups;

#ifndef MODE_ONE_LAUNCH
#define MODE_ONE_LAUNCH 1
#endif

#ifndef PROBE_Q
#define PROBE_Q -1
#endif
#ifndef PROBE_Q2
#define PROBE_Q2 -2
#endif
#if PROBE_Q >= 0
#define PROBE_MATCH(pq) ((pq) == PROBE_Q || (pq) == PROBE_Q2)
#endif
#ifndef TEST_PHASE
#define TEST_PHASE -1
#endif
#define EN(q) (TEST_PHASE < 0 || TEST_PHASE == (q))
#define LAS __attribute__((address_space(3)))
#define GAS __attribute__((address_space(1)))
typedef unsigned short bf16_t;
typedef unsigned char uchar;
typedef short bf16x8 __attribute__((ext_vector_type(8)));
typedef short s16x4 __attribute__((ext_vector_type(4)));
typedef float f32x4 __attribute__((ext_vector_type(4)));
typedef unsigned u32x4 __attribute__((ext_vector_type(4)));
typedef unsigned u32x2 __attribute__((ext_vector_type(2)));

constexpr int M_TOK = 65536, DM = 1024, SEQ = 8192, NCHUNK = 512, FF = 2816;
constexpr float EPS = 1e-6f;
constexpr int NPHASE = 24;

constexpr size_t MiB = 1024ull * 1024ull;
constexpr size_t WS_SGU_IN = 0;
constexpr size_t WS_SGU_OUT = 8 * MiB;
constexpr size_t WS_RET_IN = 12 * MiB;
constexpr size_t WS_RET_OUT = 36 * MiB;
constexpr size_t WS_GU = 44 * MiB;
constexpr size_t WS_DOWN = 88 * MiB;
constexpr size_t WS_WSM = 110 * MiB;
constexpr size_t WS_SSQ = 111 * MiB;
constexpr size_t WS_OSSQ = 115 * MiB;
constexpr size_t WS_HB = 124 * MiB;
constexpr size_t WS_BIG = 252 * MiB;
constexpr size_t WS_END = 764 * MiB;

constexpr int LDS_MAIN = 145408;
constexpr int LDS_BYTES = LDS_MAIN + 16;
constexpr size_t WS_BAR = 110 * MiB + 768 * 1024;

constexpr int BM = 256, BK = 64, HALF = 128, HTB = HALF * BK * 2, NXCD = 8, WGM = 8;

__device__ __forceinline__ int lds_byte(int r, int c) { const int st = (r >> 4) * 2 + (c >> 5), rr = r & 15, cc = c & 31, ob = rr * 64 + cc * 2; return st * 1024 + (ob ^ (((ob >> 9) & 1) << 5)); }
__device__ __forceinline__ void stage_rc(int b, int& R, int& C) { const int st = b / 1024, sb = b % 1024, swz = sb ^ (((sb >> 9) & 1) << 5); R = (st >> 1) * 16 + swz / 64; C = (st & 1) * 32 + (swz % 64) / 2; }
__device__ __forceinline__ int perm32(int rho) { const int n = rho >> 4, i = rho & 15; return 8 * (i >> 2) + 4 * n + (i & 3); }

template <class T> __device__ __forceinline__ T gld(const void* p) { return *(const GAS T*)p; }
template <class T> __device__ __forceinline__ void gst(void* p, const T v) { *(GAS T*)p = v; }
struct Ctx { int tid, bid, nblk; };
struct Unit { int pm, pn; };
struct Gemm { const bf16_t* A; const bf16_t* Bt; int M, N, K, lda, ldb; };

struct StaticOrder {
    int nM, nN, nwg, G, c;
    __device__ void init(int M, int N, int G_, int c_) { nM = M / BM; nN = N / BM; nwg = nM * nN; G = G_; c = c_; }
    __device__ bool next(int i, Unit& u) const {
        const long L = (long)i * G + c; if (L >= nwg) return false;
        int wgid = (int)L; { const int q = nwg / NXCD, r = nwg % NXCD, xcd = wgid % NXCD, off = wgid / NXCD; wgid = (xcd < r ? xcd * (q + 1) : r * (q + 1) + (xcd - r) * q) + off; }
        const int nig = WGM * nN, gid = wgid / nig, fm = gid * WGM, gsz = (nM - fm) < WGM ? (nM - fm) : WGM;
        u.pm = fm + ((wgid % nig) % gsz); u.pn = (wgid % nig) / gsz; return true;
    }
};

__device__ __forceinline__ unsigned cvt_pk_bf16(float lo, float hi) { unsigned r; asm volatile("v_cvt_pk_bf16_f32 %0, %1, %2" : "=v"(r) : "v"(lo), "v"(hi)); return r; }
__device__ __forceinline__ float bf_lo(unsigned w) { return __uint_as_float(w << 16); }
__device__ __forceinline__ float bf_hi(unsigned w) { return __uint_as_float(w & 0xffff0000u); }
__device__ __forceinline__ float fast_sigmoid(float x) { return __builtin_amdgcn_rcpf(1.0f + __builtin_amdgcn_exp2f(-1.4426950408889634f * x)); }
__device__ __forceinline__ float silu_f(float x) { return x * fast_sigmoid(x); }
__device__ __forceinline__ float gelu_tanh(float x) { const float u = 0.7978845608028654f * (x + 0.044715f * x * x * x); return x * fast_sigmoid(2.0f * u); }

__device__ __forceinline__ float row_scale(const float* ssq, int r, int fq) {
    const f32x4 p = gld<f32x4>(ssq + (size_t)r * 16 + fq * 4);
    float s = (p[0] + p[1]) + (p[2] + p[3]);
    s += __shfl_xor(s, 16); s += __shfl_xor(s, 32);
    return __builtin_amdgcn_rsqf(s * (1.0f / 1024.0f) + EPS);
}
__device__ __forceinline__ void row_scales4(const float* ssq, int row0, int fq, float (&rs)[4]) {
    f32x4 p[4];
#pragma unroll
    for (int m = 0; m < 4; ++m) p[m] = gld<f32x4>(ssq + (size_t)(row0 + m * 16) * 16 + fq * 4);
    float s[4], t[4];
#pragma unroll
    for (int m = 0; m < 4; ++m) s[m] = (p[m][0] + p[m][1]) + (p[m][2] + p[m][3]);
#pragma unroll
    for (int m = 0; m < 4; ++m) t[m] = __shfl_xor(s[m], 16);
#pragma unroll
    for (int m = 0; m < 4; ++m) s[m] += t[m];
#pragma unroll
    for (int m = 0; m < 4; ++m) t[m] = __shfl_xor(s[m], 32);
#pragma unroll
    for (int m = 0; m < 4; ++m) rs[m] = __builtin_amdgcn_rsqf((s[m] + t[m]) * (1.0f / 1024.0f) + EPS);
}
__device__ __forceinline__ void row_scales8(const float* ssq, int row0, int fq, float (&rs)[2][4]) {
    row_scales4(ssq, row0, fq, rs[0]);
    row_scales4(ssq, row0 + HALF, fq, rs[1]);
}
struct EpiCtx { LAS uchar* lds; int wid, lane, pm_fresh; };
__device__ __forceinline__ void row_scales_cached(const EpiCtx& ec, const float* ssq, int pm, int wr, int fr, float (&rs)[2][4]) {
    LAS float* buf = (LAS float*)(ec.lds + 8 * HTB + ec.wid * 512);
    if (ec.pm_fresh) {
        f32x4 p[2][4];
#pragma unroll
        for (int h = 0; h < 2; ++h) {
            const int idx = ec.lane + 64 * h, row = pm * BM + (idx >> 6) * HALF + wr * 64 + (idx & 63);
#pragma unroll
            for (int k = 0; k < 4; ++k) p[h][k] = gld<f32x4>(ssq + (size_t)row * 16 + 4 * k);
        }
#pragma unroll
        for (int h = 0; h < 2; ++h) {
            const f32x4 t = (p[h][0] + p[h][1]) + (p[h][2] + p[h][3]);
            buf[ec.lane + 64 * h] = __builtin_amdgcn_rsqf(((t[0] + t[1]) + (t[2] + t[3])) * (1.0f / 1024.0f) + EPS);
        }
    }
#pragma unroll
    for (int ai = 0; ai < 2; ++ai)
#pragma unroll
        for (int m = 0; m < 4; ++m) rs[ai][m] = buf[ai * 64 + m * 16 + fr];
}

struct EpiGelu {
    static constexpr bool DUPK = false;
    bf16_t* Z; const float* ssq;
    __device__ __forceinline__ void operator()(const f32x4 (&acc)[2][2][4][2], const Unit& u, int wr, int wc, int fr, int fq, const EpiCtx& ec) const {
        const int row0 = u.pm * BM + wr * 64 + fr, col0 = u.pn * BM + wc * 32 + 8 * fq;
        float rsv[2][4];
        row_scales_cached(ec, ssq, u.pm, wr, fr, rsv);
#pragma unroll
        for (int ai = 0; ai < 2; ++ai)
#pragma unroll
            for (int m = 0; m < 4; ++m) {
                const int r = row0 + ai * HALF + m * 16; const float rs = rsv[ai][m];
                bf16_t* rowp = Z + (size_t)r * 2048 + col0;
#pragma unroll
                for (int bj = 0; bj < 2; ++bj) {
                    const f32x4 v0 = acc[ai][bj][m][0] * rs, v1 = acc[ai][bj][m][1] * rs;
                    u32x4 w; w.x = cvt_pk_bf16(gelu_tanh(v0[0]), gelu_tanh(v0[1])); w.y = cvt_pk_bf16(gelu_tanh(v0[2]), gelu_tanh(v0[3]));
                    w.z = cvt_pk_bf16(gelu_tanh(v1[0]), gelu_tanh(v1[1])); w.w = cvt_pk_bf16(gelu_tanh(v1[2]), gelu_tanh(v1[3]));
                    gst<u32x4>(rowp + bj * HALF, w); }
            }
    }
};

struct EpiRes {
    static constexpr bool DUPK = false;
    static constexpr bool ACC_INIT = false;
    bf16_t* HB; bf16_t* HBout; float* ssq;
    __device__ __forceinline__ void operator()(const f32x4 (&acc)[2][2][4][2], const Unit& u, int wr, int wc, int fr, int fq, const EpiCtx& ec) const {
        const int row0 = u.pm * BM + wr * 64 + fr, col0 = u.pn * BM + wc * 32 + 8 * fq;
        float qv[2][4];
        u32x4 hv[2][2][2];
#define RES_LOAD(buf, b) do { _Pragma("unroll") for (int mm = 0; mm < 2; ++mm) _Pragma("unroll") for (int bj = 0; bj < 2; ++bj) \
            hv[buf][mm][bj] = gld<u32x4>(HB + (size_t)(row0 + ((b) >> 1) * HALF + (2 * ((b) & 1) + mm) * 16) * DM + col0 + bj * HALF); } while (0)
        RES_LOAD(0, 0); RES_LOAD(1, 1);
#pragma unroll
        for (int b = 0; b < 4; ++b) {
            const int ai = b >> 1;
#pragma unroll
            for (int mm = 0; mm < 2; ++mm) {
                const int m = 2 * (b & 1) + mm, r = row0 + ai * HALF + m * 16; float q = 0.f;
#pragma unroll
                for (int bj = 0; bj < 2; ++bj) {
                    const u32x4 h = hv[b & 1][mm][bj];
                    const f32x4 a0 = acc[ai][bj][m][0], a1 = acc[ai][bj][m][1];
                    const float x0 = bf_lo(h.x) + a0[0], x1 = bf_hi(h.x) + a0[1], x2 = bf_lo(h.y) + a0[2], x3 = bf_hi(h.y) + a0[3];
                    const float x4 = bf_lo(h.z) + a1[0], x5 = bf_hi(h.z) + a1[1], x6 = bf_lo(h.w) + a1[2], x7 = bf_hi(h.w) + a1[3];
                    u32x4 w; w.x = cvt_pk_bf16(x0, x1); w.y = cvt_pk_bf16(x2, x3); w.z = cvt_pk_bf16(x4, x5); w.w = cvt_pk_bf16(x6, x7);
                    gst<u32x4>(HBout + (size_t)r * DM + col0 + bj * HALF, w);
                    q += ((x0 * x0 + x1 * x1) + (x2 * x2 + x3 * x3)) + ((x4 * x4 + x5 * x5) + (x6 * x6 + x7 * x7));
                }
                qv[ai][m] = q;
            }
            if (b < 2) RES_LOAD(b & 1, b + 2);
        }
#undef RES_LOAD
        float tv[2][4];
#pragma unroll
        for (int ai = 0; ai < 2; ++ai)
#pragma unroll
            for (int m = 0; m < 4; ++m) tv[ai][m] = __shfl_xor(qv[ai][m], 16);
#pragma unroll
        for (int ai = 0; ai < 2; ++ai)
#pragma unroll
            for (int m = 0; m < 4; ++m) qv[ai][m] += tv[ai][m];
#pragma unroll
        for (int ai = 0; ai < 2; ++ai)
#pragma unroll
            for (int m = 0; m < 4; ++m) tv[ai][m] = __shfl_xor(qv[ai][m], 32);
        if (fq == 0) {
#pragma unroll
            for (int ai = 0; ai < 2; ++ai)
#pragma unroll
                for (int m = 0; m < 4; ++m) gst<float>(ssq + (size_t)(row0 + ai * HALF + m * 16) * 16 + u.pn * 4 + wc, qv[ai][m] + tv[ai][m]);
        }
    }
};

struct EpiSwiglu {
#ifdef PROBE_DUPK
    static constexpr bool DUPK = true;
#else
    static constexpr bool DUPK = false;
#endif
    bf16_t* ACT; const float* ssq;
    __device__ __forceinline__ void operator()(const f32x4 (&acc)[2][2][4][2], const Unit& u, int wr, int wc, int fr, int fq, const EpiCtx& ec) const {
        const int row0 = u.pm * BM + wr * 64 + fr, col0 = u.pn * HALF + wc * 32 + 8 * fq;
        float rsv[2][4];
        row_scales_cached(ec, ssq, u.pm, wr, fr, rsv);
#pragma unroll
        for (int ai = 0; ai < 2; ++ai)
#pragma unroll
            for (int m = 0; m < 4; ++m) {
                const int r = row0 + ai * HALF + m * 16; const float rs = rsv[ai][m];
                const float rs2 = DUPK ? rs * 0.5f : rs;
                const f32x4 a0 = acc[ai][0][m][0] * rs2, a1 = acc[ai][0][m][1] * rs2, b0 = acc[ai][1][m][0] * rs2, b1 = acc[ai][1][m][1] * rs2;
                u32x4 w; w.x = cvt_pk_bf16(silu_f(a0[0]) * b0[0], silu_f(a0[1]) * b0[1]); w.y = cvt_pk_bf16(silu_f(a0[2]) * b0[2], silu_f(a0[3]) * b0[3]);
                w.z = cvt_pk_bf16(silu_f(a1[0]) * b1[0], silu_f(a1[1]) * b1[1]); w.w = cvt_pk_bf16(silu_f(a1[2]) * b1[2], silu_f(a1[3]) * b1[3]);
                gst<u32x4>(ACT + (size_t)r * FF + col0, w);
            }
    }
};

struct EpiQKV {
    static constexpr bool DUPK = false;
    bf16_t* Q; bf16_t* Kb; bf16_t* V; const float* ssq; const int* pos;
    __device__ __forceinline__ void operator()(const f32x4 (&acc)[2][2][4][2], const Unit& u, int wr, int wc, int fr, int fq, const EpiCtx& ec) const {
        const int row0 = u.pm * BM + wr * 64 + fr, i0 = wc * 32 + 8 * fq;
        float rsa[2][4]; row_scales_cached(ec, ssq, u.pm, wr, fr, rsa);
        if (u.pn >= 8) {
            const int col0 = (u.pn - 8) * BM + i0;
#pragma unroll
            for (int ai = 0; ai < 2; ++ai) {
                float rsv[4];
#pragma unroll
                for (int m = 0; m < 4; ++m) rsv[m] = rsa[ai][m];
#pragma unroll
                for (int m = 0; m < 4; ++m) {
                    const int r = row0 + ai * HALF + m * 16; const float rs = rsv[m];
#pragma unroll
                    for (int bj = 0; bj < 2; ++bj) {
                        const f32x4 v0 = acc[ai][bj][m][0] * rs, v1 = acc[ai][bj][m][1] * rs;
                        u32x4 w; w.x = cvt_pk_bf16(v0[0], v0[1]); w.y = cvt_pk_bf16(v0[2], v0[3]); w.z = cvt_pk_bf16(v1[0], v1[1]); w.w = cvt_pk_bf16(v1[2], v1[3]);
                        gst<u32x4>(V + (size_t)r * 2048 + col0 + bj * HALF, w); }
                }
            }
        } else {
            bf16_t* dst = (u.pn < 4 ? Q : Kb) + (u.pn & 3) * BM + i0; const float sc = u.pn < 4 ? 1.0f : 0.0625f;
#pragma unroll
            for (int ai = 0; ai < 2; ++ai) {
                float rsv[4], pv[4];
#pragma unroll
                for (int m = 0; m < 4; ++m) pv[m] = (float)gld<int>(pos + row0 + ai * HALF + m * 16);
#pragma unroll
                for (int m = 0; m < 4; ++m) rsv[m] = rsa[ai][m];
#pragma unroll
                for (int m = 0; m < 4; ++m) {
                    const int r = row0 + ai * HALF + m * 16; const float rs = rsv[m] * sc; const float p = pv[m];
#pragma unroll
                    for (int n = 0; n < 2; ++n) {
                        float o1[4], o2[4];
#pragma unroll
                        for (int e = 0; e < 4; ++e) {
                            const float inv = __builtin_amdgcn_exp2f(-(float)(i0 + 4 * n + e) * (13.287712379549449f / 128.0f)) * 0.15915494309189535f;
                            float t = p * inv; t = t - floorf(t);
                            const float sn = __builtin_amdgcn_sinf(t), cs = __builtin_amdgcn_cosf(t);
                            const float x1 = acc[ai][0][m][n][e] * rs, x2 = acc[ai][1][m][n][e] * rs;
                            o1[e] = x1 * cs - x2 * sn; o2[e] = x1 * sn + x2 * cs; }
                        u32x2 w1, w2; w1.x = cvt_pk_bf16(o1[0], o1[1]); w1.y = cvt_pk_bf16(o1[2], o1[3]); w2.x = cvt_pk_bf16(o2[0], o2[1]); w2.y = cvt_pk_bf16(o2[2], o2[3]);
                        gst<u32x2>(dst + (size_t)r * DM + 4 * n, w1); gst<u32x2>(dst + (size_t)r * DM + HALF + 4 * n, w2);
                    }
                }
            }
        }
    }
};

__device__ __forceinline__ void head_scales4(const float* ossq, int row0, int head, int fq, float (&ri)[4]) {
    float q0[4], q1[4], s[4], t[4];
#pragma unroll
    for (int m = 0; m < 4; ++m) { const float* p = ossq + (size_t)(row0 + m * 16) * 32 + head * 8 + fq * 2; q0[m] = gld<float>(p); q1[m] = gld<float>(p + 1); }
#pragma unroll
    for (int m = 0; m < 4; ++m) s[m] = q0[m] + q1[m];
#pragma unroll
    for (int m = 0; m < 4; ++m) t[m] = __shfl_xor(s[m], 16);
#pragma unroll
    for (int m = 0; m < 4; ++m) s[m] += t[m];
#pragma unroll
    for (int m = 0; m < 4; ++m) t[m] = __shfl_xor(s[m], 32);
#pragma unroll
    for (int m = 0; m < 4; ++m) ri[m] = __builtin_amdgcn_rsqf((s[m] + t[m]) * (1.0f / 512.0f) + EPS);
}
struct EpiGate {
    static constexpr bool ACC_INIT = false;
    static constexpr bool DUPK = false;
    bf16_t* O; const float* ssq; const float* ossq; const float* gn;
    __device__ __forceinline__ void operator()(const f32x4 (&acc)[2][2][4][2], const Unit& u, int wr, int wc, int fr, int fq, const EpiCtx& ec) const {
        const int row0 = u.pm * BM + wr * 64 + fr, col0 = u.pn * BM + wc * 32 + 8 * fq, head = u.pn >> 1;
        float rsv[2][4], rinv[2][4];
        row_scales_cached(ec, ssq, u.pm, wr, fr, rsv);
        float q0[2][4], q1[2][4];
#pragma unroll
        for (int ai = 0; ai < 2; ++ai)
#pragma unroll
            for (int m = 0; m < 4; ++m) { const float* p = ossq + (size_t)(row0 + ai * HALF + m * 16) * 32 + head * 8 + fq * 2; q0[ai][m] = gld<float>(p); q1[ai][m] = gld<float>(p + 1); }
        f32x4 gg[2][2];
#pragma unroll
        for (int bj = 0; bj < 2; ++bj) { gg[bj][0] = gld<f32x4>(gn + col0 + bj * HALF); gg[bj][1] = gld<f32x4>(gn + col0 + bj * HALF + 4); }
        u32x4 ov[2][2][2];
#define GATE_LOAD(buf, b) do { _Pragma("unroll") for (int mm = 0; mm < 2; ++mm) _Pragma("unroll") for (int bj = 0; bj < 2; ++bj) \
            ov[buf][mm][bj] = gld<u32x4>(O + (size_t)(row0 + ((b) >> 1) * HALF + (2 * ((b) & 1) + mm) * 16) * 2048 + col0 + bj * HALF); } while (0)
        GATE_LOAD(0, 0);
        {
            float s[2][4], t[2][4];
#pragma unroll
            for (int ai = 0; ai < 2; ++ai)
#pragma unroll
                for (int m = 0; m < 4; ++m) s[ai][m] = q0[ai][m] + q1[ai][m];
#pragma unroll
            for (int ai = 0; ai < 2; ++ai)
#pragma unroll
                for (int m = 0; m < 4; ++m) t[ai][m] = __shfl_xor(s[ai][m], 16);
#pragma unroll
            for (int ai = 0; ai < 2; ++ai)
#pragma unroll
                for (int m = 0; m < 4; ++m) s[ai][m] += t[ai][m];
#pragma unroll
            for (int ai = 0; ai < 2; ++ai)
#pragma unroll
                for (int m = 0; m < 4; ++m) t[ai][m] = __shfl_xor(s[ai][m], 32);
#pragma unroll
            for (int ai = 0; ai < 2; ++ai)
#pragma unroll
                for (int m = 0; m < 4; ++m) rinv[ai][m] = __builtin_amdgcn_rsqf((s[ai][m] + t[ai][m]) * (1.0f / 512.0f) + EPS);
        }
        GATE_LOAD(1, 1);
#pragma unroll
        for (int b = 0; b < 4; ++b) {
            const int ai = b >> 1;
#pragma unroll
            for (int mm = 0; mm < 2; ++mm) {
                const int m = 2 * (b & 1) + mm, r = row0 + ai * HALF + m * 16; const float rs = rsv[ai][m], ri = rinv[ai][m];
#pragma unroll
                for (int bj = 0; bj < 2; ++bj) {
                    const u32x4 o = ov[b & 1][mm][bj];
                    const f32x4 g0 = gg[bj][0] * ri, g1 = gg[bj][1] * ri;
                    const f32x4 a0 = acc[ai][bj][m][0] * rs, a1 = acc[ai][bj][m][1] * rs;
                    u32x4 w;
                    w.x = cvt_pk_bf16(bf_lo(o.x) * g0[0] * silu_f(a0[0]), bf_hi(o.x) * g0[1] * silu_f(a0[1]));
                    w.y = cvt_pk_bf16(bf_lo(o.y) * g0[2] * silu_f(a0[2]), bf_hi(o.y) * g0[3] * silu_f(a0[3]));
                    w.z = cvt_pk_bf16(bf_lo(o.z) * g1[0] * silu_f(a1[0]), bf_hi(o.z) * g1[1] * silu_f(a1[1]));
                    w.w = cvt_pk_bf16(bf_lo(o.w) * g1[2] * silu_f(a1[2]), bf_hi(o.w) * g1[3] * silu_f(a1[3]));
                    gst<u32x4>(O + (size_t)r * 2048 + col0 + bj * HALF, w); }
            }
            if (b < 2) GATE_LOAD(b & 1, b + 2);
        }
#undef GATE_LOAD
    }
};

template <class Epi>
__device__ __forceinline__ void gemm_phase(const Ctx cx, LAS uchar* lds, const Gemm g, const StaticOrder& S, const Epi& E) {
    const int tid = cx.tid, wid = __builtin_amdgcn_readfirstlane(tid >> 6), lane = tid & 63, wr = wid >> 2, wc = wid & 3, fr = lane & 15, fq = lane >> 4;
    const int K = g.K, nt = K / BK;
    unsigned voffA[2], voffB[2];
#pragma unroll
    for (int i = 0; i < 2; ++i) { int R, C; stage_rc(tid * 16 + i * 8192, R, C); const int Rb = (R & ~31) + perm32(R & 31);
        voffA[i] = (unsigned)(R * g.lda + C) * 2u; voffB[i] = (unsigned)(Rb * g.ldb + C) * 2u; }
    const size_t kstep = (size_t)(BK * 2);
    const size_t hstepA = (size_t)HALF * g.lda * 2, hstepB = (size_t)HALF * g.ldb * 2;
    const size_t tstepA = 2 * hstepA, tstepB = 2 * hstepB;
    const unsigned ldsw = (unsigned)wid * 1024u;
    const int aoff = lds_byte(wr * 64 + fr, fq * 8), boff = lds_byte(wc * 32 + fr, fq * 8);
#define PG8_SA(b, h) (((b) * 2 + (h)) * HTB)
#define PG8_SB(b, h) ((4 + (b) * 2 + (h)) * HTB)
#define PG8_STAGE(bufoff, gbase, voff) do { const char* _gb = (const char*)(gbase); asm volatile("" : "+s"(_gb));   \
    _Pragma("unroll") for (int _i = 0; _i < 2; ++_i) { asm volatile("" : "+v"((voff)[_i]));   \
        __builtin_amdgcn_global_load_lds((const unsigned*)(_gb + (voff)[_i]), (LAS unsigned*)(lds + (bufoff) + ldsw + _i * 8192), 16, 0, 0); } } while (0)
#define PG8_LDA(dst, b, h) do { _Pragma("unroll") for (int m = 0; m < 4; ++m) _Pragma("unroll") for (int k = 0; k < 2; ++k) dst[m][k] = *(const LAS bf16x8*)(lds + PG8_SA(b, h) + aoff + m * 2048 + k * 1024); } while (0)
#define PG8_LDB(dst, b, h) do { _Pragma("unroll") for (int n = 0; n < 2; ++n) _Pragma("unroll") for (int k = 0; k < 2; ++k) dst[n][k] = *(const LAS bf16x8*)(lds + PG8_SB(b, h) + boff + n * 2048 + k * 1024); } while (0)
#define PG8_MMA(ai, bj, At, Bt) do { __builtin_amdgcn_s_setprio(3); _Pragma("unroll") for (int m = 0; m < 4; ++m) _Pragma("unroll") for (int n = 0; n < 2; ++n) _Pragma("unroll") for (int k = 0; k < 2; ++k) \
        acc[ai][bj][m][n] = __builtin_amdgcn_mfma_f32_16x16x32_bf16(Bt[n][k], At[m][k], acc[ai][bj][m][n], 0, 0, 0); __builtin_amdgcn_s_setprio(0); } while (0)
#define PG8_WAIT_V(n) asm volatile("s_waitcnt vmcnt(" #n ")" ::: "memory")
#define PG8_WAIT_L(n) asm volatile("s_waitcnt lgkmcnt(" #n ")" ::: "memory")
#define PG8_BAR __builtin_amdgcn_s_barrier()
#define PG8_SCHED __builtin_amdgcn_sched_barrier(0)
    Unit cur, nxt; int ui = 0; int prev_pm = -1;
    if (!S.next(0, cur)) return;
    f32x4 acc[2][2][4][2];
#pragma unroll
    for (int a = 0; a < 2; ++a)
#pragma unroll
        for (int b = 0; b < 2; ++b)
#pragma unroll
            for (int m = 0; m < 4; ++m)
#pragma unroll
                for (int n = 0; n < 2; ++n) acc[a][b][m][n] = (f32x4){0.f, 0.f, 0.f, 0.f};
    bf16x8 At[4][2], B0[2][2], B1[2][2];
    const char* cA = (const char*)g.A + (size_t)cur.pm * tstepA; const char* cB = (const char*)g.Bt + (size_t)cur.pn * tstepB;
    PG8_STAGE(PG8_SB(0, 0), cB, voffB); PG8_STAGE(PG8_SA(0, 0), cA, voffA); PG8_STAGE(PG8_SB(0, 1), cB + hstepB, voffB); PG8_STAGE(PG8_SA(0, 1), cA + hstepA, voffA);
    if (wr == 1) PG8_BAR;
    PG8_WAIT_V(4); PG8_BAR;
    PG8_STAGE(PG8_SB(1, 0), cB + kstep, voffB); PG8_STAGE(PG8_SA(1, 0), cA + kstep, voffA); PG8_STAGE(PG8_SB(1, 1), cB + hstepB + kstep, voffB);
    PG8_WAIT_V(6); PG8_BAR;
    for (;;) {
        const bool has_next = S.next(ui + 1, nxt);
        const char* nA = has_next ? (const char*)g.A + (size_t)nxt.pm * tstepA : cA; const char* nB = has_next ? (const char*)g.Bt + (size_t)nxt.pn * tstepB : cB;
        for (int tt = 0; tt < (Epi::DUPK ? 2 : 1) * nt; tt += 2) {
            const int t = tt < nt ? tt : tt - nt;
            const bool last = (tt == (Epi::DUPK ? 2 : 1) * nt - 2);
            const int t2 = (t + 2 == nt) ? 0 : t + 2;
            const char* a1 = cA + (size_t)(t + 1) * kstep;
            const char* a2 = last ? nA : cA + (size_t)t2 * kstep; const char* b2 = last ? nB : cB + (size_t)t2 * kstep;
            const char* a3 = a2 + kstep; const char* b3 = b2 + kstep;
            PG8_LDB(B0, 0, 0); PG8_SCHED; PG8_LDA(At, 0, 0); PG8_STAGE(PG8_SA(1, 1), a1 + hstepA, voffA);
            PG8_WAIT_L(8); PG8_BAR; PG8_WAIT_L(0); PG8_MMA(0, 0, At, B0); PG8_BAR; PG8_SCHED;
            PG8_LDB(B1, 0, 1); PG8_STAGE(PG8_SB(0, 0), b2, voffB);
            PG8_BAR; PG8_WAIT_L(0); PG8_MMA(0, 1, At, B1); PG8_BAR;
            PG8_LDA(At, 0, 1); PG8_STAGE(PG8_SA(0, 0), a2, voffA);
            PG8_BAR; PG8_WAIT_L(0); PG8_MMA(1, 0, At, B0); PG8_BAR; PG8_SCHED;
            PG8_STAGE(PG8_SB(0, 1), b2 + hstepB, voffB);
            PG8_WAIT_V(6); PG8_BAR; PG8_MMA(1, 1, At, B1); PG8_BAR;
            PG8_LDB(B0, 1, 0); PG8_SCHED; PG8_LDA(At, 1, 0); PG8_STAGE(PG8_SA(0, 1), a2 + hstepA, voffA);
            PG8_WAIT_L(8); PG8_BAR; PG8_WAIT_L(0); PG8_MMA(0, 0, At, B0); PG8_BAR; PG8_SCHED;
            PG8_LDB(B1, 1, 1); PG8_STAGE(PG8_SB(1, 0), b3, voffB);
            PG8_BAR; PG8_WAIT_L(0); PG8_MMA(0, 1, At, B1); PG8_BAR;
            PG8_LDA(At, 1, 1); PG8_STAGE(PG8_SA(1, 0), a3, voffA);
            PG8_BAR; PG8_WAIT_L(0); PG8_MMA(1, 0, At, B0); PG8_BAR; PG8_SCHED;
            PG8_STAGE(PG8_SB(1, 1), b3 + hstepB, voffB);
            PG8_WAIT_V(6); PG8_BAR; PG8_MMA(1, 1, At, B1); PG8_BAR;
        }
        {
            int fr_e = fr, fq_e = fq; asm volatile("" : "+v"(fr_e), "+v"(fq_e));
            EpiCtx ec; ec.lds = lds; ec.wid = wid; ec.lane = fr_e + 16 * fq_e; ec.pm_fresh = (cur.pm != prev_pm); prev_pm = cur.pm;
            E(acc, cur, wr, wc, fr_e, fq_e, ec);
        }
        if (!has_next) break;
#pragma unroll
        for (int a = 0; a < 2; ++a)
#pragma unroll
            for (int b = 0; b < 2; ++b)
#pragma unroll
                for (int m = 0; m < 4; ++m)
#pragma unroll
                    for (int n = 0; n < 2; ++n) acc[a][b][m][n] = (f32x4){0.f, 0.f, 0.f, 0.f};
        cur = nxt; cA = nA; cB = nB; ++ui;
    }
    PG8_WAIT_V(0);
    if (wr == 0) PG8_BAR;
    PG8_BAR;
#undef PG8_SA
#undef PG8_SB
#undef PG8_STAGE
#undef PG8_LDA
#undef PG8_LDB
#undef PG8_MMA
#undef PG8_WAIT_V
#undef PG8_WAIT_L
#undef PG8_BAR
#undef PG8_SCHED
}

struct Args {
    const float* x; const int* pos; const float* mix_g; const float* ffn_g; const float* fin_g;
    const float* sgu_w_in; const float* sgu_w_s; const float* sgu_b_s; const float* sgu_ln_g; const float* sgu_ln_b; const float* sgu_w_out;
    const float* ret_w_in; const float* ret_gn_g; const float* ret_w_out; const float* ffn_w_gu; const float* ffn_w_down;
    float* out; uchar* ws; int ph_lo, ph_hi;
};

struct TileJob { const float* W; bf16_t* Wt; const float* gain; int K, N, tk, src0, n0; };
__device__ __forceinline__ TileJob decode_tile(const Args& a, uchar* ws, int tile) {
    TileJob t; int r, mode = 0, ntk;
    if (tile < 5632) {
        const int j = tile / 2816; r = tile - j * 2816;
        if (r < 512)       { t.W = a.sgu_w_in + (size_t)j * 1024 * 2048; t.Wt = (bf16_t*)(ws + WS_SGU_IN) + (size_t)j * 2048 * 1024; t.gain = a.mix_g + (2 * j) * 1024; t.K = 1024; t.N = 2048; }
        else if (r < 768)  { r -= 512;  t.W = a.sgu_w_out + (size_t)j * 1024 * 1024; t.Wt = (bf16_t*)(ws + WS_SGU_OUT) + (size_t)j * 1024 * 1024; t.gain = nullptr; t.K = 1024; t.N = 1024; }
        else if (r < 2304) { r -= 768;  t.W = a.ret_w_in + (size_t)j * 1024 * 6144; t.Wt = (bf16_t*)(ws + WS_RET_IN) + (size_t)j * 6144 * 1024; t.gain = a.mix_g + (2 * j + 1) * 1024; t.K = 1024; t.N = 6144; }
        else               { r -= 2304; t.W = a.ret_w_out + (size_t)j * 2048 * 1024; t.Wt = (bf16_t*)(ws + WS_RET_OUT) + (size_t)j * 1024 * 2048; t.gain = nullptr; t.K = 2048; t.N = 1024; }
    } else {
        const int t2 = tile - 5632, i = t2 / 2112; r = t2 - i * 2112;
        if (r < 1408) { t.W = a.ffn_w_gu + (size_t)i * 1024 * 5632; t.Wt = (bf16_t*)(ws + WS_GU) + (size_t)i * 5632 * 1024; t.gain = a.ffn_g + i * 1024; t.K = 1024; t.N = 5632; mode = 1; }
        else          { r -= 1408; t.W = a.ffn_w_down + (size_t)i * FF * 1024; t.Wt = (bf16_t*)(ws + WS_DOWN) + (size_t)i * 1024 * FF; t.gain = nullptr; t.K = FF; t.N = 1024; }
    }
    ntk = t.K / 64; t.tk = r % ntk; t.n0 = (r / ntk) * 64; t.src0 = t.n0;
    if (mode == 1) { const int tt = t.n0 >> 8, half = (t.n0 >> 7) & 1, jj = t.n0 & 127; t.src0 = half * FF + tt * 128 + jj; }
    return t;
}
constexpr int N_WTILES = 5632 + 8448;

__device__ __forceinline__ void x_row_finish(const f32x4 (&v)[4], int r, int lane, bf16_t* HB, float* ssq) {
    float q = 0.f;
#pragma unroll
    for (int i = 0; i < 4; ++i) {
        const int c = i * 256 + lane * 4;
        u32x2 w; w.x = cvt_pk_bf16(v[i][0], v[i][1]); w.y = cvt_pk_bf16(v[i][2], v[i][3]);
        gst<u32x2>(HB + (size_t)r * DM + c, w);
        q += (bf_lo(w.x) * bf_lo(w.x) + bf_hi(w.x) * bf_hi(w.x)) + (bf_lo(w.y) * bf_lo(w.y) + bf_hi(w.y) * bf_hi(w.y));
    }
#pragma unroll
    for (int o = 32; o >= 1; o >>= 1) q += __shfl_xor(q, o);
    if (lane < 16) gst<float>(ssq + (size_t)r * 16 + lane, (lane == 0) ? q : 0.f);
}

__device__ __forceinline__ void prep_phase(const Ctx cx, LAS uchar* lds, const Args& a) {
    LAS float* tile = (LAS float*)lds;
    uchar* ws = a.ws;
    bf16_t* HB = (bf16_t*)(ws + WS_HB); float* ssq = (float*)(ws + WS_SSQ);
    const int lane = cx.tid & 63, gw = cx.bid * 8 + (cx.tid >> 6), nw = cx.nblk * 8;
    int xr = gw;
    {
        const int tid = cx.tid, kl = tid >> 4, nl4 = (tid & 15) * 4, nl = tid >> 3, kc = (tid & 7) * 8;
        f32x4 v[2]; float gsc[2]; f32x4 xv[4];
        int cur = cx.bid;
        TileJob tj = decode_tile(a, ws, cur < N_WTILES ? cur : 0);
#pragma unroll
        for (int pass = 0; pass < 2; ++pass) { const int k = tj.tk * 64 + pass * 32 + kl; v[pass] = gld<f32x4>(tj.W + (size_t)k * tj.N + tj.src0 + nl4); gsc[pass] = tj.gain ? gld<float>(tj.gain + k) : 1.0f; }
        if (xr < M_TOK) {
#pragma unroll
            for (int i = 0; i < 4; ++i) xv[i] = gld<f32x4>(a.x + (size_t)xr * DM + i * 256 + lane * 4);
        }
        for (; cur < N_WTILES; cur += cx.nblk) {
#pragma unroll
            for (int pass = 0; pass < 2; ++pass) {
                LAS float* tp = tile + (pass * 32 + kl) * 65 + nl4;
                tp[0] = v[pass][0] * gsc[pass]; tp[1] = v[pass][1] * gsc[pass]; tp[2] = v[pass][2] * gsc[pass]; tp[3] = v[pass][3] * gsc[pass];
            }
            __syncthreads();
            const TileJob tc = tj;
            const int nxt = cur + cx.nblk;
            if (nxt < N_WTILES) {
                tj = decode_tile(a, ws, nxt);
#pragma unroll
                for (int pass = 0; pass < 2; ++pass) { const int k = tj.tk * 64 + pass * 32 + kl; v[pass] = gld<f32x4>(tj.W + (size_t)k * tj.N + tj.src0 + nl4); gsc[pass] = tj.gain ? gld<float>(tj.gain + k) : 1.0f; }
            }
            float e[8];
#pragma unroll
            for (int i = 0; i < 8; ++i) e[i] = tile[(kc + i) * 65 + nl];
            u32x4 w; w.x = cvt_pk_bf16(e[0], e[1]); w.y = cvt_pk_bf16(e[2], e[3]); w.z = cvt_pk_bf16(e[4], e[5]); w.w = cvt_pk_bf16(e[6], e[7]);
            gst<u32x4>(tc.Wt + (size_t)(tc.n0 + nl) * tc.K + tc.tk * 64 + kc, w);
            if (xr < M_TOK) {
                x_row_finish(xv, xr, lane, HB, ssq);
                xr += nw;
                if (xr < M_TOK) {
#pragma unroll
                    for (int i = 0; i < 4; ++i) xv[i] = gld<f32x4>(a.x + (size_t)xr * DM + i * 256 + lane * 4);
                }
            }
            __syncthreads();
        }
        while (xr < M_TOK) {
            x_row_finish(xv, xr, lane, HB, ssq);
            xr += nw;
            if (xr < M_TOK) {
#pragma unroll
                for (int i = 0; i < 4; ++i) xv[i] = gld<f32x4>(a.x + (size_t)xr * DM + i * 256 + lane * 4);
            }
        }
    }
    {
        bf16_t* wm = (bf16_t*)(ws + WS_WSM);
        const int total = 2 * 8 * 128 * 128;
        for (int i = (cx.bid * 512 + cx.tid) * 2; i < total; i += cx.nblk * 512 * 2) {
            const int s = i & 127, t = (i >> 7) & 127;
            const float v0 = (s <= t) ? gld<float>(a.sgu_w_s + i) : 0.f, v1 = (s + 1 <= t) ? gld<float>(a.sgu_w_s + i + 1) : 0.f;
            gst<unsigned>(wm + i, cvt_pk_bf16(v0, v1));
        }
    }
}

__device__ __forceinline__ void final_phase(const Ctx cx, const Args& a) {
    const int lane = cx.tid & 63, gw = cx.bid * 8 + (cx.tid >> 6), nw = cx.nblk * 8;
    float* H = a.out; const bf16_t* HB = (const bf16_t*)(a.ws + WS_HB); const float* ssq = (const float*)(a.ws + WS_SSQ);
    for (int r = gw; r < M_TOK; r += nw) {
        float s = gld<float>(ssq + (size_t)r * 16 + (lane & 15));
        s += __shfl_xor(s, 1); s += __shfl_xor(s, 2); s += __shfl_xor(s, 4); s += __shfl_xor(s, 8);
        const float rs = rsqrtf(s * (1.0f / 1024.0f) + EPS);
#pragma unroll
        for (int i = 0; i < 4; ++i) {
            const int c = i * 256 + lane * 4;
            const u32x2 hv = gld<u32x2>(HB + (size_t)r * DM + c); const f32x4 g = gld<f32x4>(a.fin_g + c);
            const f32x4 v = (f32x4){bf_lo(hv.x), bf_hi(hv.x), bf_lo(hv.y), bf_hi(hv.y)};
            gst<f32x4>(H + (size_t)r * DM + c, v * rs * g);
        }
    }
}

__device__ __forceinline__ s16x4 tr_read(LAS uchar* p) { return __builtin_amdgcn_ds_read_tr16_b64_v4i16((LAS s16x4*)p); }
__device__ __forceinline__ bf16x8 cat8(s16x4 a, s16x4 b) { return __builtin_shufflevector(a, b, 0, 1, 2, 3, 4, 5, 6, 7); }

__device__ __forceinline__ void sgu_mix_phase(const Ctx cx, LAS uchar* lds, bf16_t* Z, bf16_t* Zout, const bf16_t* Wm, const float* bs, const float* lng, const float* lnb) {
    constexpr int VST = 288;
    LAS float* stats = (LAS float*)lds;
    LAS uchar* vimg = lds + 1024;
    LAS float* lgb = (LAS float*)(lds + 1024 + 128 * VST);
    const int tid = cx.tid, wid = __builtin_amdgcn_readfirstlane(tid >> 6), lane = tid & 63, fr = lane & 15, fq = lane >> 4;
    const int q4 = fr >> 2, p4 = fr & 3;
    __syncthreads();
    for (int i = tid; i < 2048; i += 512) lgb[i] = gld<float>((i < 1024 ? lng : lnb - 1024) + i);
    for (int chunk = cx.bid; chunk < NCHUNK; chunk += cx.nblk) {
        bf16_t* zc = Z + (size_t)chunk * 128 * 2048;
        __syncthreads();
#pragma unroll 1
        for (int i4 = 0; i4 < 4; ++i4) {
            u32x4 ra[4], rb[4];
#pragma unroll
            for (int i = 0; i < 4; ++i) { const bf16_t* p = zc + (size_t)(wid * 16 + i4 * 4 + i) * 2048 + 1024 + lane * 16; ra[i] = gld<u32x4>(p); rb[i] = gld<u32x4>(p + 8); }
            float s[4], q[4];
#pragma unroll
            for (int i = 0; i < 4; ++i) {
                s[i] = 0.f; q[i] = 0.f;
#pragma unroll
                for (int e = 0; e < 4; ++e) { const float x0 = bf_lo(ra[i][e]), x1 = bf_hi(ra[i][e]), x2 = bf_lo(rb[i][e]), x3 = bf_hi(rb[i][e]); s[i] += (x0 + x1) + (x2 + x3); q[i] += (x0 * x0 + x1 * x1) + (x2 * x2 + x3 * x3); }
            }
#pragma unroll
            for (int o = 32; o >= 1; o >>= 1) {
                float ts[4], tq[4];
#pragma unroll
                for (int i = 0; i < 4; ++i) { ts[i] = __shfl_xor(s[i], o); tq[i] = __shfl_xor(q[i], o); }
#pragma unroll
                for (int i = 0; i < 4; ++i) { s[i] += ts[i]; q[i] += tq[i]; }
            }
            if (lane < 4) {
                const float sv = lane == 0 ? s[0] : lane == 1 ? s[1] : lane == 2 ? s[2] : s[3], qv = lane == 0 ? q[0] : lane == 1 ? q[1] : lane == 2 ? q[2] : q[3];
                const float mean = sv * (1.0f / 1024.0f); const float var = qv * (1.0f / 1024.0f) - mean * mean;
                const int row = wid * 16 + i4 * 4 + lane;
                stats[row * 2] = mean; stats[row * 2 + 1] = __builtin_amdgcn_rsqf(fmaxf(var, 0.f) + EPS);
            }
        }
        const int fs = tid >> 2, dseg = (tid & 3) * 32;
        u32x4 raw[4];
#pragma unroll
        for (int i = 0; i < 4; ++i) raw[i] = gld<u32x4>(zc + (size_t)fs * 2048 + 1024 + dseg + i * 8);
#pragma unroll 1
        for (int g = 0; g < 8; ++g) {
            __syncthreads();
            {
                const float mean = stats[fs * 2], rstd = stats[fs * 2 + 1];
#pragma unroll
                for (int i = 0; i < 4; ++i) {
                    const int d = g * 128 + dseg + i * 8;
                    const f32x4 g0 = *(const LAS f32x4*)(lgb + d) * rstd, g1 = *(const LAS f32x4*)(lgb + d + 4) * rstd, b0 = *(const LAS f32x4*)(lgb + 1024 + d), b1 = *(const LAS f32x4*)(lgb + 1024 + d + 4);
                    u32x4 w;
                    w.x = cvt_pk_bf16((bf_lo(raw[i].x) - mean) * g0[0] + b0[0], (bf_hi(raw[i].x) - mean) * g0[1] + b0[1]);
                    w.y = cvt_pk_bf16((bf_lo(raw[i].y) - mean) * g0[2] + b0[2], (bf_hi(raw[i].y) - mean) * g0[3] + b0[3]);
                    w.z = cvt_pk_bf16((bf_lo(raw[i].z) - mean) * g1[0] + b1[0], (bf_hi(raw[i].z) - mean) * g1[1] + b1[1]);
                    w.w = cvt_pk_bf16((bf_lo(raw[i].w) - mean) * g1[2] + b1[2], (bf_hi(raw[i].w) - mean) * g1[3] + b1[3]);
                    *(LAS u32x4*)(vimg + fs * VST + (dseg + i * 8) * 2) = w;
                }
            }
            const int t = 16 * wid + fr;
            bf16x8 wf[4]; u32x2 uu[8];
#pragma unroll
            for (int kk = 0; kk < 4; ++kk) wf[kk] = gld<bf16x8>(Wm + ((size_t)(g * 128 + t)) * 128 + 32 * kk + 8 * fq);
            const size_t ubase = (size_t)chunk * 128 * 2048 + (size_t)t * 2048 + g * 128 + 4 * fq;
#pragma unroll
            for (int nd = 0; nd < 8; ++nd) uu[nd] = gld<u32x2>(Z + ubase + 16 * nd);
            const float bias = gld<float>(bs + g * 128 + t);
            if (g < 7) {
#pragma unroll
                for (int i = 0; i < 4; ++i) raw[i] = gld<u32x4>(zc + (size_t)fs * 2048 + 1024 + (g + 1) * 128 + dseg + i * 8);
            }
            __syncthreads();
            f32x4 acc[8];
#pragma unroll
            for (int nd = 0; nd < 8; ++nd) acc[nd] = (f32x4){0.f, 0.f, 0.f, 0.f};
            const int kkmax = (16 * wid + 15) >> 5;
#pragma unroll
            for (int kk = 0; kk < 4; ++kk) {
                if (kk <= kkmax) {
#pragma unroll
                    for (int nd = 0; nd < 8; ++nd) {
                        LAS uchar* ap = vimg + (32 * kk + 8 * fq + q4) * VST + (16 * nd + 4 * p4) * 2;
                        const bf16x8 vf = cat8(tr_read(ap), tr_read(ap + 4 * VST));
                        acc[nd] = __builtin_amdgcn_mfma_f32_16x16x32_bf16(vf, wf[kk], acc[nd], 0, 0, 0);
                    }
                }
            }
#pragma unroll
            for (int nd = 0; nd < 8; ++nd) {
                u32x2 w; w.x = cvt_pk_bf16(bf_lo(uu[nd].x) * (acc[nd][0] + bias), bf_hi(uu[nd].x) * (acc[nd][1] + bias)); w.y = cvt_pk_bf16(bf_lo(uu[nd].y) * (acc[nd][2] + bias), bf_hi(uu[nd].y) * (acc[nd][3] + bias));
                gst<u32x2>(Zout + ubase + 16 * nd, w);
            }
        }
    }
}

__device__ __forceinline__ void retention_phase(const Ctx cx, LAS uchar* lds, const bf16_t* Q, const bf16_t* Kb, const bf16_t* V, bf16_t* Oout, float* ossq) {
    constexpr int KST = 544, VST = 160, SST = 544;
    LAS uchar* kR = lds;
    LAS uchar* vR = lds + 69632;
    LAS uchar* vS = vR + 20480;
    LAS uchar* ST = vS + 20480;
    const int tid0 = cx.tid, wid = __builtin_amdgcn_readfirstlane(tid0 >> 6);
    const int tw = wid < 4 ? wid : 11 - wid;
    for (int item = cx.bid; item < 256; item += cx.nblk) {
        const int xcd = item & 7, local = item >> 3, pairi = xcd * 4 + (local >> 3);
        const int j = local & 7, h = pairi & 3, b = pairi >> 2;
        const float lg = log2f(1.0f - exp2f(-5.0f - (float)h));
        const float chunk_decay = exp2f(128.0f * lg);
        __syncthreads();
        for (int i = tid0; i < 34816 / 16; i += 512) ((LAS u32x4*)ST)[i] = (u32x4){0u, 0u, 0u, 0u};
        f32x4 accS[2][4];
#pragma unroll
        for (int dl = 0; dl < 2; ++dl)
#pragma unroll
            for (int vt = 0; vt < 4; ++vt) accS[dl][vt] = (f32x4){0.f, 0.f, 0.f, 0.f};
        u32x4 kreg[8]; u32x4 vreg[2]; bf16x8 qn[8];
        const float rowfac = __builtin_amdgcn_exp2f((float)(16 * tw + (tid0 & 15)) * lg), g16i = __builtin_amdgcn_exp2f(-16.0f * lg);
        float colfac[4];
#pragma unroll
        for (int jj = 0; jj < 4; ++jj) colfac[jj] = __builtin_amdgcn_exp2f(-(float)(4 * ((tid0 & 63) >> 4) + jj) * lg);
        {
            const size_t r0 = (size_t)b * SEQ;
            const int lane = tid0 & 63, fr = lane & 15, fq = lane >> 4;
#pragma unroll
            for (int i = 0; i < 8; ++i) { const int idx = tid0 + 512 * i, s = idx >> 5, ch = idx & 31; kreg[i] = gld<u32x4>(Kb + (r0 + s) * DM + h * 256 + ch * 8); }
            { const int s = tid0 >> 2, c16 = (tid0 & 3) * 16; const bf16_t* vp = V + (r0 + s) * 2048 + h * 512 + j * 64 + c16; vreg[0] = gld<u32x4>(vp); vreg[1] = gld<u32x4>(vp + 8); }
#pragma unroll
            for (int kk = 0; kk < 8; ++kk) qn[kk] = gld<bf16x8>(Q + (r0 + 16 * tw + fr) * DM + h * 256 + 32 * kk + 8 * fq);
        }
        for (int c = 0; c < 64; ++c) {
            const size_t r0 = (size_t)b * SEQ + (size_t)c * 128;
            int tid = tid0; asm volatile("" : "+v"(tid));
            const int lane = tid & 63, fr = lane & 15, fq = lane >> 4, q4 = fr >> 2, p4 = fr & 3;
            bf16x8 qf[8];
            __syncthreads();
#pragma unroll
            for (int i = 0; i < 8; ++i) { const int idx = tid + 512 * i, s = idx >> 5, ch = idx & 31; *(LAS u32x4*)(kR + s * KST + ch * 16) = kreg[i]; }
            {
                const int s = tid >> 2, c16 = (tid & 3) * 16; const float sd = __builtin_amdgcn_exp2f((float)(127 - s) * lg);
#pragma unroll
                for (int i = 0; i < 2; ++i) {
                    *(LAS u32x4*)(vR + s * VST + c16 * 2 + i * 16) = vreg[i];
                    u32x4 w;
                    w.x = cvt_pk_bf16(bf_lo(vreg[i].x) * sd, bf_hi(vreg[i].x) * sd); w.y = cvt_pk_bf16(bf_lo(vreg[i].y) * sd, bf_hi(vreg[i].y) * sd);
                    w.z = cvt_pk_bf16(bf_lo(vreg[i].z) * sd, bf_hi(vreg[i].z) * sd); w.w = cvt_pk_bf16(bf_lo(vreg[i].w) * sd, bf_hi(vreg[i].w) * sd);
                    *(LAS u32x4*)(vS + s * VST + c16 * 2 + i * 16) = w;
                }
            }
#pragma unroll
            for (int kk = 0; kk < 8; ++kk) qf[kk] = qn[kk];
            if (c > 0) {
#pragma unroll
                for (int dl = 0; dl < 2; ++dl)
#pragma unroll
                    for (int vt = 0; vt < 4; ++vt) {
                        u32x2 w; w.x = cvt_pk_bf16(accS[dl][vt][0], accS[dl][vt][1]); w.y = cvt_pk_bf16(accS[dl][vt][2], accS[dl][vt][3]);
                        *(LAS u32x2*)(ST + (16 * vt + fr) * SST + (16 * (2 * wid + dl) + 4 * fq) * 2) = w;
                    }
            }
            __syncthreads();
            {
                const size_t rn = (size_t)b * SEQ + (size_t)(c < 63 ? c + 1 : 63) * 128;
#pragma unroll
                for (int i = 0; i < 8; ++i) { const int idx = tid + 512 * i, s = idx >> 5, ch = idx & 31; kreg[i] = gld<u32x4>(Kb + (rn + s) * DM + h * 256 + ch * 8); }
                { const int s = tid >> 2, c16 = (tid & 3) * 16; const bf16_t* vp = V + (rn + s) * 2048 + h * 512 + j * 64 + c16; vreg[0] = gld<u32x4>(vp); vreg[1] = gld<u32x4>(vp + 8); }
            }
            f32x4 accX[4], accI[4];
#pragma unroll
            for (int vt = 0; vt < 4; ++vt) { accX[vt] = (f32x4){0.f, 0.f, 0.f, 0.f}; accI[vt] = (f32x4){0.f, 0.f, 0.f, 0.f}; }
            {
                bf16x8 sa[8];
#pragma unroll
                for (int i = 0; i < 8; ++i) sa[i] = *(const LAS bf16x8*)(ST + (16 * (i & 3) + fr) * SST + (32 * (i >> 2) + 8 * fq) * 2);
#pragma unroll
                for (int r = 0; r < 4; ++r) {
                    __builtin_amdgcn_sched_barrier(0);
                    __builtin_amdgcn_s_setprio(3);
#pragma unroll
                    for (int i = 0; i < 8; ++i) accX[i & 3] = __builtin_amdgcn_mfma_f32_16x16x32_bf16(sa[i], qf[2 * r + (i >> 2)], accX[i & 3], 0, 0, 0);
                    __builtin_amdgcn_s_setprio(0);
                    __builtin_amdgcn_sched_barrier(0);
                    if (r < 3) {
#pragma unroll
                        for (int i = 0; i < 8; ++i) sa[i] = *(const LAS bf16x8*)(ST + (16 * (i & 3) + fr) * SST + (32 * (2 * (r + 1) + (i >> 2)) + 8 * fq) * 2);
                    }
                }
            }
            const int t_in = 16 * tw + fr;
#pragma unroll
            for (int kk2 = 0; kk2 < 4; ++kk2) {
                if (kk2 <= (tw >> 1)) {
                    f32x4 accP0 = (f32x4){0.f, 0.f, 0.f, 0.f}, accP1 = (f32x4){0.f, 0.f, 0.f, 0.f};
#pragma unroll
                    for (int kh = 0; kh < 2; ++kh) {
                        bf16x8 af0[4], af1[4];
#pragma unroll
                        for (int k4 = 0; k4 < 4; ++k4) {
                            af0[k4] = *(const LAS bf16x8*)(kR + (32 * kk2 + fr) * KST + (32 * (4 * kh + k4) + 8 * fq) * 2);
                            af1[k4] = *(const LAS bf16x8*)(kR + (32 * kk2 + 16 + fr) * KST + (32 * (4 * kh + k4) + 8 * fq) * 2);
                        }
                        __builtin_amdgcn_sched_barrier(0);
                        __builtin_amdgcn_s_setprio(3);
#pragma unroll
                        for (int k4 = 0; k4 < 4; ++k4) {
                            accP0 = __builtin_amdgcn_mfma_f32_16x16x32_bf16(af0[k4], qf[4 * kh + k4], accP0, 0, 0, 0);
                            accP1 = __builtin_amdgcn_mfma_f32_16x16x32_bf16(af1[k4], qf[4 * kh + k4], accP1, 0, 0, 0);
                        }
                        __builtin_amdgcn_s_setprio(0);
                    }
                    float pv[8];
                    float rf = rowfac; asm volatile("" : "+v"(rf));
                    const float f0 = rf * __builtin_amdgcn_exp2f(-32.0f * (float)kk2 * lg), f1 = f0 * g16i;
#pragma unroll
                    for (int jj = 0; jj < 4; ++jj) { pv[jj] = accP0[jj] * (f0 * colfac[jj]); pv[4 + jj] = accP1[jj] * (f1 * colfac[jj]); }
                    if (kk2 == (tw >> 1)) {
#pragma unroll
                        for (int jj = 0; jj < 4; ++jj) {
                            const int d0 = t_in - (32 * kk2 + 4 * fq + jj);
                            pv[jj] = d0 >= 0 ? pv[jj] : 0.f; pv[4 + jj] = d0 >= 16 ? pv[4 + jj] : 0.f;
                        }
                    }
                    u32x4 pw; pw.x = cvt_pk_bf16(pv[0], pv[1]); pw.y = cvt_pk_bf16(pv[2], pv[3]); pw.z = cvt_pk_bf16(pv[4], pv[5]); pw.w = cvt_pk_bf16(pv[6], pv[7]);
                    const bf16x8 pf = __builtin_bit_cast(bf16x8, pw);
#pragma unroll
                    for (int vt = 0; vt < 4; ++vt) {
                        LAS uchar* ap = vR + (32 * kk2 + 4 * fq + q4) * VST + (16 * vt + 4 * p4) * 2;
                        const bf16x8 vf = cat8(tr_read(ap), tr_read(ap + 16 * VST));
                        accI[vt] = __builtin_amdgcn_mfma_f32_16x16x32_bf16(vf, pf, accI[vt], 0, 0, 0);
                    }
                }
            }
            {
                const size_t rn = (size_t)b * SEQ + (size_t)(c < 63 ? c + 1 : 63) * 128;
#pragma unroll
                for (int kk = 0; kk < 8; ++kk) qn[kk] = gld<bf16x8>(Q + (rn + 16 * tw + fr) * DM + h * 256 + 32 * kk + 8 * fq);
            }
            {
                const float cd = __builtin_amdgcn_exp2f((float)(t_in + 1) * lg);
                float q = 0.f;
                bf16_t* op = Oout + (r0 + t_in) * 2048 + h * 512 + j * 64 + 4 * fq;
#pragma unroll
                for (int vt = 0; vt < 4; ++vt) {
                    const f32x4 o = accI[vt] + accX[vt] * cd;
                    q += (o[0] * o[0] + o[1] * o[1]) + (o[2] * o[2] + o[3] * o[3]);
                    u32x2 w; w.x = cvt_pk_bf16(o[0], o[1]); w.y = cvt_pk_bf16(o[2], o[3]);
                    gst<u32x2>(op + 16 * vt, w);
                }
                q += __shfl_xor(q, 16); q += __shfl_xor(q, 32);
                if (fq == 0) gst<float>(ossq + (r0 + t_in) * 32 + h * 8 + j, q);
            }
#pragma unroll
            for (int dl = 0; dl < 2; ++dl)
#pragma unroll
                for (int vt = 0; vt < 4; ++vt) accS[dl][vt] = accS[dl][vt] * chunk_decay;
            {
                bf16x8 vf[2][4], kf[2][2];
#define RET_LOAD_STATE_OPS(buf, kk2) do { \
                    _Pragma("unroll") for (int vt = 0; vt < 4; ++vt) { LAS uchar* bp = vS + (32 * (kk2) + 4 * fq + q4) * VST + (16 * vt + 4 * p4) * 2; vf[buf][vt] = cat8(tr_read(bp), tr_read(bp + 16 * VST)); } \
                    _Pragma("unroll") for (int dl = 0; dl < 2; ++dl) { LAS uchar* ap = kR + (32 * (kk2) + 4 * fq + q4) * KST + (16 * (2 * wid + dl) + 4 * p4) * 2; kf[buf][dl] = cat8(tr_read(ap), tr_read(ap + 16 * KST)); } } while (0)
                RET_LOAD_STATE_OPS(0, 0);
#pragma unroll
                for (int kk2 = 0; kk2 < 4; ++kk2) {
                    if (kk2 < 3) RET_LOAD_STATE_OPS((kk2 + 1) & 1, kk2 + 1);
                    __builtin_amdgcn_sched_barrier(0);
                    __builtin_amdgcn_s_setprio(3);
#pragma unroll
                    for (int dl = 0; dl < 2; ++dl)
#pragma unroll
                        for (int vt = 0; vt < 4; ++vt) accS[dl][vt] = __builtin_amdgcn_mfma_f32_16x16x32_bf16(kf[kk2 & 1][dl], vf[kk2 & 1][vt], accS[dl][vt], 0, 0, 0);
                    __builtin_amdgcn_s_setprio(0);
                    __builtin_amdgcn_sched_barrier(0);
                }
#undef RET_LOAD_STATE_OPS
            }
        }
    }
}

#define XB_TMO      128
#define XB_XCNT(j)  (256  + 64 * (j))
#define XB_XSUB(j)  (1280 + 64 * (j))
#define XB_XGEN(j)  (2304 + 64 * (j))
#define XB_TOP      3328
#define XB_TOPGEN   3392
#define XCD_BAR_WORDS 3456
#define XB_SPIN_CAP (1u << 22)
__device__ __forceinline__ unsigned xb_ld(unsigned* p)              { return __hip_atomic_load(p, __ATOMIC_RELAXED, __HIP_MEMORY_SCOPE_AGENT); }
__device__ __forceinline__ unsigned xb_add(unsigned* p, unsigned v) { return __hip_atomic_fetch_add(p, v, __ATOMIC_RELAXED, __HIP_MEMORY_SCOPE_AGENT); }
__device__ __forceinline__ unsigned xb_xcc_id() { return (unsigned)__builtin_amdgcn_s_getreg((3 << 11) | 20) & 0xFu; }
#define XB_SPIN(cond, bar) do { unsigned _sp = 0; while (cond) { __builtin_amdgcn_s_sleep(1); \
    if ((++_sp & 255u) == 0u) { if (xb_ld(&(bar)[XB_TMO])) break; if (_sp > XB_SPIN_CAP) { atomicAdd(&(bar)[XB_TMO], 1u); break; } } } } while (0)
struct XcdBarrier { unsigned* bar; unsigned x; volatile LAS unsigned* st; };
__device__ __forceinline__ XcdBarrier xcd_barrier_post(unsigned* bar, volatile LAS unsigned* st) {
    XcdBarrier b; b.bar = bar; b.x = xb_xcc_id(); b.st = st;
    if (threadIdx.x == 0) (void)xb_add(&bar[XB_XCNT(b.x)], 1u);
    return b;
}
__device__ __forceinline__ void xcd_barrier_complete(unsigned* bar, unsigned x, unsigned& nloc, unsigned& nx) {
    const unsigned G = gridDim.x * gridDim.y * gridDim.z;
    unsigned sum, cnt, mine, sp = 0u;
    for (;;) {
        sum = 0u; cnt = 0u; mine = 0u;
#pragma unroll
        for (unsigned j = 0; j < 16; ++j) { const unsigned c = xb_ld(&bar[XB_XCNT(j)]); sum += c; cnt += (c > 0u) ? 1u : 0u; mine = (j == x) ? c : mine; }
        if (sum == G) break;
        __builtin_amdgcn_s_sleep(1);
        if ((++sp & 255u) == 0u) { if (xb_ld(&bar[XB_TMO])) break; if (sp > XB_SPIN_CAP) { atomicAdd(&bar[XB_TMO], 1u); break; } }
    }
    nloc = mine > 0u ? mine : 1u; nx = cnt > 0u ? cnt : 1u;
}
__device__ __forceinline__ void xcd_barrier(const XcdBarrier& b) {
    asm volatile("s_waitcnt vmcnt(0)" ::: "memory");
    __syncthreads();
    if (threadIdx.x == 0) {
        unsigned* bar = b.bar;
        __builtin_amdgcn_s_waitcnt(0);
        unsigned nloc = b.st[0], nx = b.st[1];
        if (nloc == 0u) { xcd_barrier_complete(bar, b.x, nloc, nx); b.st[0] = nloc; b.st[1] = nx; }
        const unsigned old = xb_add(&bar[XB_XSUB(b.x)], 1u);
        const unsigned gen = old / nloc;
        if (old + 1u == (gen + 1u) * nloc) {
            __builtin_amdgcn_fence(__ATOMIC_RELEASE, "agent");
            asm volatile("s_waitcnt vmcnt(0)" ::: "memory");
            const unsigned og = xb_add(&bar[XB_TOP], 1u);
            const unsigned tg = og / nx;
            if (og + 1u == (tg + 1u) * nx) xb_add(&bar[XB_TOPGEN], 1u);
            else XB_SPIN(xb_ld(&bar[XB_TOPGEN]) == tg, bar);
            __builtin_amdgcn_fence(__ATOMIC_ACQUIRE, "agent");
            xb_add(&bar[XB_XGEN(b.x)], 1u);
            asm volatile("s_waitcnt vmcnt(0)" ::: "memory");
        } else {
            XB_SPIN(xb_ld(&bar[XB_XGEN(b.x)]) == gen, bar);
            __builtin_amdgcn_fence(__ATOMIC_ACQUIRE, "agent");
            asm volatile("s_waitcnt vmcnt(0)" ::: "memory");
        }
    }
    __syncthreads();
}

__global__ void __launch_bounds__(512, 2) mega_fwd(Args a_kernarg) {
#if defined(__HIP_DEVICE_COMPILE__)
    typedef const __attribute__((address_space(4))) Args* KArgs;
    KArgs kap = (KArgs)__builtin_amdgcn_kernarg_segment_ptr();
    const int ph_lo = a_kernarg.ph_lo, ph_hi = a_kernarg.ph_hi;
    extern __shared__ __attribute__((aligned(16))) uchar shm[];
    LAS uchar* lds = (LAS uchar*)shm;
    XcdBarrier bar; bar.bar = nullptr; bar.x = 0; bar.st = (volatile LAS unsigned*)(lds + LDS_MAIN);
    if (ph_hi - ph_lo > 1) {
        if (threadIdx.x < 4) bar.st[threadIdx.x] = 0u;
        __syncthreads();
        bar = xcd_barrier_post((unsigned*)(a_kernarg.ws + WS_BAR), bar.st);
    }
    int probe_rep = 0; (void)probe_rep;
    for (int ph = ph_lo; ph < ph_hi; ++ph) {
        KArgs kapl = kap; asm volatile("" : "+s"(kapl));
        const Args a = *kapl;
        Ctx cx; cx.tid = threadIdx.x; cx.bid = blockIdx.x; cx.nblk = gridDim.x;
        asm volatile("" : "+v"(cx.tid)); asm volatile("" : "+s"(cx.bid)); asm volatile("" : "+s"(cx.nblk));
        uchar* ws = a.ws; asm volatile("" : "+s"(ws));
        float* H = a.out; asm volatile("" : "+s"(H));
        bf16_t* HB = (bf16_t*)(ws + WS_HB); float* ssq = (float*)(ws + WS_SSQ); float* ossq = (float*)(ws + WS_OSSQ);
        bf16_t* BIG = (bf16_t*)(ws + WS_BIG);
        bf16_t* Qb = BIG; bf16_t* Kb = BIG + (size_t)M_TOK * 1024; bf16_t* Vb = BIG + (size_t)M_TOK * 2048;
        StaticOrder S;
        if (ph == 0) { if constexpr (EN(100)) prep_phase(cx, lds, a); }
        else if (ph == NPHASE - 1) { if constexpr (EN(101)) final_phase(cx, a); }
        else {
            const int p = ph - 1, pair = p / 11, q = p % 11;
            const int L = 2 * pair + (q >= 5 ? 1 : 0);
            switch (q) {
            case 0: if constexpr (EN(0)) {
                Gemm g{HB, (const bf16_t*)(ws + WS_SGU_IN) + (size_t)pair * 2048 * 1024, M_TOK, 2048, 1024, 1024, 1024};
                S.init(M_TOK, 2048, cx.nblk, cx.bid); EpiGelu E{BIG, ssq}; gemm_phase<EpiGelu>(cx, lds, g, S, E); } break;
            case 1:
                if constexpr (EN(1)) sgu_mix_phase(cx, lds, BIG,
#if PROBE_Q == 1
                    (!probe_rep) ? (bf16_t*)(ws + WS_END) :
#endif
                    BIG, (const bf16_t*)(ws + WS_WSM) + (size_t)pair * 8 * 128 * 128, a.sgu_b_s + pair * 8 * 128, a.sgu_ln_g + pair * 1024, a.sgu_ln_b + pair * 1024);
                break;
            case 2: case 4: case 8: case 10: if constexpr (EN(2)) {
                Gemm g;
                if (q == 2) g = Gemm{BIG, (const bf16_t*)(ws + WS_SGU_OUT) + (size_t)pair * 1024 * 1024, M_TOK, 1024, 1024, 2048, 1024};
                else if (q == 8) g = Gemm{Vb, (const bf16_t*)(ws + WS_RET_OUT) + (size_t)pair * 1024 * 2048, M_TOK, 1024, 2048, 2048, 2048};
                else g = Gemm{BIG, (const bf16_t*)(ws + WS_DOWN) + (size_t)L * 1024 * FF, M_TOK, 1024, FF, FF, FF};
                S.init(M_TOK, 1024, cx.nblk, cx.bid); EpiRes E{HB, HB, ssq};
#if defined(PROBE_RES)
                if (!probe_rep && PROBE_MATCH(q)) E.HBout = (bf16_t*)(ws + WS_END);
#endif
                gemm_phase<EpiRes>(cx, lds, g, S, E); } break;
            case 3: case 9: if constexpr (EN(3)) {
                Gemm g{HB, (const bf16_t*)(ws + WS_GU) + (size_t)L * 5632 * 1024, M_TOK, 5632, 1024, 1024, 1024};
                S.init(M_TOK, 5632, cx.nblk, cx.bid); EpiSwiglu E{BIG, ssq}; gemm_phase<EpiSwiglu>(cx, lds, g, S, E); } break;
            case 5: if constexpr (EN(5)) {
                Gemm g{HB, (const bf16_t*)(ws + WS_RET_IN) + (size_t)pair * 6144 * 1024, M_TOK, 4096, 1024, 1024, 1024};
                S.init(M_TOK, 4096, cx.nblk, cx.bid); EpiQKV E{Qb, Kb, Vb, ssq, a.pos}; gemm_phase<EpiQKV>(cx, lds, g, S, E); } break;
            case 6:
                if constexpr (EN(6)) {
#if PROBE_Q == 6
                    if (!probe_rep) retention_phase(cx, lds, Qb, Kb, Vb, (bf16_t*)(ws + WS_END), ossq); else
#endif
                    retention_phase(cx, lds, Qb, Kb, Vb, Vb, ossq); }
                break;
            case 7: if constexpr (EN(7)) {
                Gemm g{HB, (const bf16_t*)(ws + WS_RET_IN) + (size_t)pair * 6144 * 1024 + (size_t)4096 * 1024, M_TOK, 2048, 1024, 1024, 1024};
                S.init(M_TOK, 2048, cx.nblk, cx.bid); EpiGate E{Vb, ssq, ossq, a.ret_gn_g + pair * 2048}; gemm_phase<EpiGate>(cx, lds, g, S, E); } break;
            default: break;
            }
        }
        if (ph + 1 < ph_hi) {
            if (ph < 0) { __threadfence(); cg::this_grid().sync(); }
            else xcd_barrier(bar);
        }
#if defined(PROBE_MATCH)
        {
            const int pq = (ph == 0) ? 100 : (ph == NPHASE - 1) ? 101 : ((ph - 1) % 11);
            if (PROBE_MATCH(pq) && !probe_rep) { probe_rep = 1; --ph; } else probe_rep = 0;
        }
#endif
    }
#endif
}

extern "C" void kernel_launch(void* const* d_in, const int* in_sizes, int n_in, void* d_out, int out_size, void* d_ws, size_t ws_size, hipStream_t stream) {
    static int grid = 0;
    if (grid == 0) {
        if (n_in != 16 || out_size != M_TOK * DM || ws_size < WS_END) { fprintf(stderr, "kernel_launch: unexpected shapes (n_in %d out %d ws %zu)\n", n_in, out_size, ws_size); grid = -1; return; }
        int dev = 0, cus = 0, per_cu = 0;
        hipGetDevice(&dev); hipDeviceGetAttribute(&cus, hipDeviceAttributeMultiprocessorCount, dev);
        if (hipFuncSetAttribute((const void*)mega_fwd, hipFuncAttributeMaxDynamicSharedMemorySize, LDS_BYTES) != hipSuccess) { fprintf(stderr, "kernel_launch: hipFuncSetAttribute failed\n"); grid = -1; return; }
        if (hipOccupancyMaxActiveBlocksPerMultiprocessor(&per_cu, (const void*)mega_fwd, 512, LDS_BYTES) != hipSuccess || per_cu < 1) per_cu = 1;
        (void)hipGetLastError();
        grid = cus * per_cu;
    }
    if (grid < 0) return;
    Args a{};
    a.x = (const float*)d_in[0]; a.pos = (const int*)d_in[1]; a.mix_g = (const float*)d_in[2]; a.ffn_g = (const float*)d_in[3]; a.fin_g = (const float*)d_in[4];
    a.sgu_w_in = (const float*)d_in[5]; a.sgu_w_s = (const float*)d_in[6]; a.sgu_b_s = (const float*)d_in[7]; a.sgu_ln_g = (const float*)d_in[8]; a.sgu_ln_b = (const float*)d_in[9];
    a.sgu_w_out = (const float*)d_in[10]; a.ret_w_in = (const float*)d_in[11]; a.ret_gn_g = (const float*)d_in[12]; a.ret_w_out = (const float*)d_in[13];
    a.ffn_w_gu = (const float*)d_in[14]; a.ffn_w_down = (const float*)d_in[15];
    a.out = (float*)d_out; a.ws = (uchar*)d_ws;
#if MODE_ONE_LAUNCH
    a.ph_lo = 0; a.ph_hi = NPHASE;
    if (hipMemsetAsync((uchar*)d_ws + WS_BAR, 0, 16384, stream) != hipSuccess) { fprintf(stderr, "kernel_launch: memset of the barrier words failed\n"); return; }
    void* args[] = {&a};
    hipError_t e = hipLaunchCooperativeKernel((const void*)mega_fwd, dim3(grid), dim3(512), args, LDS_BYTES, stream);
    if (e != hipSuccess) fprintf(stderr, "cooperative launch failed: %s (grid %d)\n", hipGetErrorString(e), grid);
#else
    for (int ph = 0; ph < NPHASE; ++ph) {
        a.ph_lo = ph; a.ph_hi = ph + 1;
        hipLaunchKernelGGL(mega_fwd, dim3(grid), dim3(512), LDS_BYTES, stream, a);
    }
#endif
}
```

```cpp
#include <hip/hip_runtime.h>
#include <hip/hip_cooperative_groups.h>
#include <cstdio>
namespace cg = cooperative_groups;

#ifndef MODE_ONE_LAUNCH
#define MODE_ONE_LAUNCH 1
#endif

#ifndef PROBE_Q
#define PROBE_Q -1
#endif
#ifndef PROBE_Q2
#define PROBE_Q2 -2
#endif
#if PROBE_Q >= 0
#define PROBE_MATCH(pq) ((pq) == PROBE_Q || (pq) == PROBE_Q2)
#endif
#ifndef TEST_PHASE
#define TEST_PHASE -1
#endif
#define EN(q) (TEST_PHASE < 0 || TEST_PHASE == (q))
#define LAS __attribute__((address_space(3)))
#define GAS __attribute__((address_space(1)))
typedef unsigned short bf16_t;
typedef unsigned char uchar;
typedef short bf16x8 __attribute__((ext_vector_type(8)));
typedef short s16x4 __attribute__((ext_vector_type(4)));
typedef float f32x4 __attribute__((ext_vector_type(4)));
typedef unsigned u32x4 __attribute__((ext_vector_type(4)));
typedef unsigned u32x2 __attribute__((ext_vector_type(2)));

constexpr int M_TOK = 65536, DM = 1024, SEQ = 8192, NCHUNK = 512, FF = 2816;
constexpr float EPS = 1e-6f;
constexpr int NPHASE = 24;

constexpr size_t MiB = 1024ull * 1024ull;
constexpr size_t WS_SGU_IN = 0;
constexpr size_t WS_SGU_OUT = 8 * MiB;
constexpr size_t WS_RET_IN = 12 * MiB;
constexpr size_t WS_RET_OUT = 36 * MiB;
constexpr size_t WS_GU = 44 * MiB;
constexpr size_t WS_DOWN = 88 * MiB;
constexpr size_t WS_WSM = 110 * MiB;
constexpr size_t WS_SSQ = 111 * MiB;
constexpr size_t WS_OSSQ = 115 * MiB;
constexpr size_t WS_HB = 124 * MiB;
constexpr size_t WS_BIG = 252 * MiB;
constexpr size_t WS_END = 764 * MiB;

constexpr int LDS_MAIN = 145408;
constexpr int LDS_BYTES = LDS_MAIN + 16;
constexpr size_t WS_BAR = 110 * MiB + 768 * 1024;

constexpr int BM = 256, BK = 64, HALF = 128, HTB = HALF * BK * 2, NXCD = 8, WGM = 8;

__device__ __forceinline__ int lds_byte(int r, int c) { const int st = (r >> 4) * 2 + (c >> 5), rr = r & 15, cc = c & 31, ob = rr * 64 + cc * 2; return st * 1024 + (ob ^ (((ob >> 9) & 1) << 5)); }
__device__ __forceinline__ void stage_rc(int b, int& R, int& C) { const int st = b / 1024, sb = b % 1024, swz = sb ^ (((sb >> 9) & 1) << 5); R = (st >> 1) * 16 + swz / 64; C = (st & 1) * 32 + (swz % 64) / 2; }
__device__ __forceinline__ int perm32(int rho) { const int n = rho >> 4, i = rho & 15; return 8 * (i >> 2) + 4 * n + (i & 3); }

template <class T> __device__ __forceinline__ T gld(const void* p) { return *(const GAS T*)p; }
template <class T> __device__ __forceinline__ void gst(void* p, const T v) { *(GAS T*)p = v; }
struct Ctx { int tid, bid, nblk; };
struct Unit { int pm, pn; };
struct Gemm { const bf16_t* A; const bf16_t* Bt; int M, N, K, lda, ldb; };

struct StaticOrder {
    int nM, nN, nwg, G, c, rev;
    __device__ void init(int M, int N, int G_, int c_, int rev_ = 0) { nM = M / BM; nN = N / BM; nwg = nM * nN; G = G_; c = c_; rev = rev_; }
    __device__ bool next(int i, Unit& u) const {
        const long L = (long)i * G + c; if (L >= nwg) return false;
        int wgid = (int)L; { const int q = nwg / NXCD, r = nwg % NXCD, xcd = wgid % NXCD; int off = wgid / NXCD; if (rev) off = q + (xcd < r ? 1 : 0) - 1 - off; wgid = (xcd < r ? xcd * (q + 1) : r * (q + 1) + (xcd - r) * q) + off; }
        const int nig = WGM * nN, gid = wgid / nig, fm = gid * WGM, gsz = (nM - fm) < WGM ? (nM - fm) : WGM;
        u.pm = fm + ((wgid % nig) % gsz); u.pn = (wgid % nig) / gsz; return true;
    }
};

__device__ __forceinline__ unsigned cvt_pk_bf16(float lo, float hi) { unsigned r; asm volatile("v_cvt_pk_bf16_f32 %0, %1, %2" : "=v"(r) : "v"(lo), "v"(hi)); return r; }
__device__ __forceinline__ float bf_lo(unsigned w) { return __uint_as_float(w << 16); }
__device__ __forceinline__ float bf_hi(unsigned w) { return __uint_as_float(w & 0xffff0000u); }
__device__ __forceinline__ float fast_sigmoid(float x) { return __builtin_amdgcn_rcpf(1.0f + __builtin_amdgcn_exp2f(-1.4426950408889634f * x)); }
__device__ __forceinline__ float silu_f(float x) { return x * fast_sigmoid(x); }
__device__ __forceinline__ float gelu_tanh(float x) { const float u = 0.7978845608028654f * (x + 0.044715f * x * x * x); return x * fast_sigmoid(2.0f * u); }

__device__ __forceinline__ float row_scale(const float* ssq, int r, int fq) {
    const f32x4 p = gld<f32x4>(ssq + (size_t)r * 16 + fq * 4);
    float s = (p[0] + p[1]) + (p[2] + p[3]);
    s += __shfl_xor(s, 16); s += __shfl_xor(s, 32);
    return __builtin_amdgcn_rsqf(s * (1.0f / 1024.0f) + EPS);
}
__device__ __forceinline__ void row_scales4(const float* ssq, int row0, int fq, float (&rs)[4]) {
    f32x4 p[4];
#pragma unroll
    for (int m = 0; m < 4; ++m) p[m] = gld<f32x4>(ssq + (size_t)(row0 + m * 16) * 16 + fq * 4);
    float s[4], t[4];
#pragma unroll
    for (int m = 0; m < 4; ++m) s[m] = (p[m][0] + p[m][1]) + (p[m][2] + p[m][3]);
#pragma unroll
    for (int m = 0; m < 4; ++m) t[m] = __shfl_xor(s[m], 16);
#pragma unroll
    for (int m = 0; m < 4; ++m) s[m] += t[m];
#pragma unroll
    for (int m = 0; m < 4; ++m) t[m] = __shfl_xor(s[m], 32);
#pragma unroll
    for (int m = 0; m < 4; ++m) rs[m] = __builtin_amdgcn_rsqf((s[m] + t[m]) * (1.0f / 1024.0f) + EPS);
}
__device__ __forceinline__ void row_scales8(const float* ssq, int row0, int fq, float (&rs)[2][4]) {
    row_scales4(ssq, row0, fq, rs[0]);
    row_scales4(ssq, row0 + HALF, fq, rs[1]);
}
struct EpiCtx { LAS uchar* lds; int wid, lane, pm_fresh; };
__device__ __forceinline__ void row_scales_cached(const EpiCtx& ec, const float* ssq, int pm, int wr, int fr, float (&rs)[2][4]) {
    LAS float* buf = (LAS float*)(ec.lds + 8 * HTB + ec.wid * 512);
    if (ec.pm_fresh) {
        f32x4 p[2][4];
#pragma unroll
        for (int h = 0; h < 2; ++h) {
            const int idx = ec.lane + 64 * h, row = pm * BM + (idx >> 6) * HALF + wr * 64 + (idx & 63);
#pragma unroll
            for (int k = 0; k < 4; ++k) p[h][k] = gld<f32x4>(ssq + (size_t)row * 16 + 4 * k);
        }
#pragma unroll
        for (int h = 0; h < 2; ++h) {
            const f32x4 t = (p[h][0] + p[h][1]) + (p[h][2] + p[h][3]);
            buf[ec.lane + 64 * h] = __builtin_amdgcn_rsqf(((t[0] + t[1]) + (t[2] + t[3])) * (1.0f / 1024.0f) + EPS);
        }
    }
#pragma unroll
    for (int ai = 0; ai < 2; ++ai)
#pragma unroll
        for (int m = 0; m < 4; ++m) rs[ai][m] = buf[ai * 64 + m * 16 + fr];
}

struct EpiGelu {
    static constexpr bool DUPK = false;
    bf16_t* Z; const float* ssq;
    __device__ __forceinline__ void operator()(const f32x4 (&acc)[2][2][4][2], const Unit& u, int wr, int wc, int fr, int fq, const EpiCtx& ec) const {
        const int row0 = u.pm * BM + wr * 64 + fr, col0 = u.pn * BM + wc * 32 + 8 * fq;
        float rsv[2][4];
        row_scales_cached(ec, ssq, u.pm, wr, fr, rsv);
#pragma unroll
        for (int ai = 0; ai < 2; ++ai)
#pragma unroll
            for (int m = 0; m < 4; ++m) {
                const int r = row0 + ai * HALF + m * 16; const float rs = rsv[ai][m];
                bf16_t* rowp = Z + (size_t)r * 2048 + col0;
#pragma unroll
                for (int bj = 0; bj < 2; ++bj) {
                    const f32x4 v0 = acc[ai][bj][m][0] * rs, v1 = acc[ai][bj][m][1] * rs;
                    u32x4 w; w.x = cvt_pk_bf16(gelu_tanh(v0[0]), gelu_tanh(v0[1])); w.y = cvt_pk_bf16(gelu_tanh(v0[2]), gelu_tanh(v0[3]));
                    w.z = cvt_pk_bf16(gelu_tanh(v1[0]), gelu_tanh(v1[1])); w.w = cvt_pk_bf16(gelu_tanh(v1[2]), gelu_tanh(v1[3]));
                    gst<u32x4>(rowp + bj * HALF, w); }
            }
    }
};

struct EpiRes {
    static constexpr bool DUPK = false;
    static constexpr bool ACC_INIT = false;
    bf16_t* HB; bf16_t* HBout; float* ssq;
    __device__ __forceinline__ void operator()(const f32x4 (&acc)[2][2][4][2], const Unit& u, int wr, int wc, int fr, int fq, const EpiCtx& ec) const {
        const int row0 = u.pm * BM + wr * 64 + fr, col0 = u.pn * BM + wc * 32 + 8 * fq;
        float qv[2][4];
        u32x4 hv[2][2][2];
#define RES_LOAD(buf, b) do { _Pragma("unroll") for (int mm = 0; mm < 2; ++mm) _Pragma("unroll") for (int bj = 0; bj < 2; ++bj) \
            hv[buf][mm][bj] = gld<u32x4>(HB + (size_t)(row0 + ((b) >> 1) * HALF + (2 * ((b) & 1) + mm) * 16) * DM + col0 + bj * HALF); } while (0)
        RES_LOAD(0, 0); RES_LOAD(1, 1);
#pragma unroll
        for (int b = 0; b < 4; ++b) {
            const int ai = b >> 1;
#pragma unroll
            for (int mm = 0; mm < 2; ++mm) {
                const int m = 2 * (b & 1) + mm, r = row0 + ai * HALF + m * 16; float q = 0.f;
#pragma unroll
                for (int bj = 0; bj < 2; ++bj) {
                    const u32x4 h = hv[b & 1][mm][bj];
                    const f32x4 a0 = acc[ai][bj][m][0], a1 = acc[ai][bj][m][1];
                    const float x0 = bf_lo(h.x) + a0[0], x1 = bf_hi(h.x) + a0[1], x2 = bf_lo(h.y) + a0[2], x3 = bf_hi(h.y) + a0[3];
                    const float x4 = bf_lo(h.z) + a1[0], x5 = bf_hi(h.z) + a1[1], x6 = bf_lo(h.w) + a1[2], x7 = bf_hi(h.w) + a1[3];
                    u32x4 w; w.x = cvt_pk_bf16(x0, x1); w.y = cvt_pk_bf16(x2, x3); w.z = cvt_pk_bf16(x4, x5); w.w = cvt_pk_bf16(x6, x7);
                    gst<u32x4>(HBout + (size_t)r * DM + col0 + bj * HALF, w);
                    q += ((x0 * x0 + x1 * x1) + (x2 * x2 + x3 * x3)) + ((x4 * x4 + x5 * x5) + (x6 * x6 + x7 * x7));
                }
                qv[ai][m] = q;
            }
            if (b < 2) RES_LOAD(b & 1, b + 2);
        }
#undef RES_LOAD
        float tv[2][4];
#pragma unroll
        for (int ai = 0; ai < 2; ++ai)
#pragma unroll
            for (int m = 0; m < 4; ++m) tv[ai][m] = __shfl_xor(qv[ai][m], 16);
#pragma unroll
        for (int ai = 0; ai < 2; ++ai)
#pragma unroll
            for (int m = 0; m < 4; ++m) qv[ai][m] += tv[ai][m];
#pragma unroll
        for (int ai = 0; ai < 2; ++ai)
#pragma unroll
            for (int m = 0; m < 4; ++m) tv[ai][m] = __shfl_xor(qv[ai][m], 32);
        if (fq == 0) {
#pragma unroll
            for (int ai = 0; ai < 2; ++ai)
#pragma unroll
                for (int m = 0; m < 4; ++m) gst<float>(ssq + (size_t)(row0 + ai * HALF + m * 16) * 16 + u.pn * 4 + wc, qv[ai][m] + tv[ai][m]);
        }
    }
};

struct EpiSwiglu {
#ifdef PROBE_DUPK
    static constexpr bool DUPK = true;
#else
    static constexpr bool DUPK = false;
#endif
    bf16_t* ACT; const float* ssq;
    __device__ __forceinline__ void operator()(const f32x4 (&acc)[2][2][4][2], const Unit& u, int wr, int wc, int fr, int fq, const EpiCtx& ec) const {
        const int row0 = u.pm * BM + wr * 64 + fr, col0 = u.pn * HALF + wc * 32 + 8 * fq;
        float rsv[2][4];
        row_scales_cached(ec, ssq, u.pm, wr, fr, rsv);
#pragma unroll
        for (int ai = 0; ai < 2; ++ai)
#pragma unroll
            for (int m = 0; m < 4; ++m) {
                const int r = row0 + ai * HALF + m * 16; const float rs = rsv[ai][m];
                const float rs2 = DUPK ? rs * 0.5f : rs;
                const f32x4 a0 = acc[ai][0][m][0] * rs2, a1 = acc[ai][0][m][1] * rs2, b0 = acc[ai][1][m][0] * rs2, b1 = acc[ai][1][m][1] * rs2;
                u32x4 w; w.x = cvt_pk_bf16(silu_f(a0[0]) * b0[0], silu_f(a0[1]) * b0[1]); w.y = cvt_pk_bf16(silu_f(a0[2]) * b0[2], silu_f(a0[3]) * b0[3]);
                w.z = cvt_pk_bf16(silu_f(a1[0]) * b1[0], silu_f(a1[1]) * b1[1]); w.w = cvt_pk_bf16(silu_f(a1[2]) * b1[2], silu_f(a1[3]) * b1[3]);
                gst<u32x4>(ACT + (size_t)r * FF + col0, w);
            }
    }
};

struct EpiQKV {
    static constexpr bool DUPK = false;
    bf16_t* Q; bf16_t* Kb; bf16_t* V; const float* ssq; const int* pos;
    __device__ __forceinline__ void operator()(const f32x4 (&acc)[2][2][4][2], const Unit& u, int wr, int wc, int fr, int fq, const EpiCtx& ec) const {
        const int row0 = u.pm * BM + wr * 64 + fr, i0 = wc * 32 + 8 * fq;
        float rsa[2][4]; row_scales_cached(ec, ssq, u.pm, wr, fr, rsa);
        if (u.pn >= 8) {
            const int col0 = (u.pn - 8) * BM + i0;
#pragma unroll
            for (int ai = 0; ai < 2; ++ai) {
                float rsv[4];
#pragma unroll
                for (int m = 0; m < 4; ++m) rsv[m] = rsa[ai][m];
#pragma unroll
                for (int m = 0; m < 4; ++m) {
                    const int r = row0 + ai * HALF + m * 16; const float rs = rsv[m];
#pragma unroll
                    for (int bj = 0; bj < 2; ++bj) {
                        const f32x4 v0 = acc[ai][bj][m][0] * rs, v1 = acc[ai][bj][m][1] * rs;
                        u32x4 w; w.x = cvt_pk_bf16(v0[0], v0[1]); w.y = cvt_pk_bf16(v0[2], v0[3]); w.z = cvt_pk_bf16(v1[0], v1[1]); w.w = cvt_pk_bf16(v1[2], v1[3]);
                        gst<u32x4>(V + (size_t)r * 2048 + col0 + bj * HALF, w); }
                }
            }
        } else {
            bf16_t* dst = (u.pn < 4 ? Q : Kb) + (u.pn & 3) * BM + i0; const float sc = u.pn < 4 ? 1.0f : 0.0625f;
#pragma unroll
            for (int ai = 0; ai < 2; ++ai) {
                float rsv[4], pv[4];
#pragma unroll
                for (int m = 0; m < 4; ++m) pv[m] = (float)gld<int>(pos + row0 + ai * HALF + m * 16);
#pragma unroll
                for (int m = 0; m < 4; ++m) rsv[m] = rsa[ai][m];
#pragma unroll
                for (int m = 0; m < 4; ++m) {
                    const int r = row0 + ai * HALF + m * 16; const float rs = rsv[m] * sc; const float p = pv[m];
#pragma unroll
                    for (int n = 0; n < 2; ++n) {
                        float o1[4], o2[4];
#pragma unroll
                        for (int e = 0; e < 4; ++e) {
                            const float inv = __builtin_amdgcn_exp2f(-(float)(i0 + 4 * n + e) * (13.287712379549449f / 128.0f)) * 0.15915494309189535f;
                            float t = p * inv; t = t - floorf(t);
                            const float sn = __builtin_amdgcn_sinf(t), cs = __builtin_amdgcn_cosf(t);
                            const float x1 = acc[ai][0][m][n][e] * rs, x2 = acc[ai][1][m][n][e] * rs;
                            o1[e] = x1 * cs - x2 * sn; o2[e] = x1 * sn + x2 * cs; }
                        u32x2 w1, w2; w1.x = cvt_pk_bf16(o1[0], o1[1]); w1.y = cvt_pk_bf16(o1[2], o1[3]); w2.x = cvt_pk_bf16(o2[0], o2[1]); w2.y = cvt_pk_bf16(o2[2], o2[3]);
                        gst<u32x2>(dst + (size_t)r * DM + 4 * n, w1); gst<u32x2>(dst + (size_t)r * DM + HALF + 4 * n, w2);
                    }
                }
            }
        }
    }
};

__device__ __forceinline__ void head_scales4(const float* ossq, int row0, int head, int fq, float (&ri)[4]) {
    float q0[4], q1[4], s[4], t[4];
#pragma unroll
    for (int m = 0; m < 4; ++m) { const float* p = ossq + (size_t)(row0 + m * 16) * 32 + head * 8 + fq * 2; q0[m] = gld<float>(p); q1[m] = gld<float>(p + 1); }
#pragma unroll
    for (int m = 0; m < 4; ++m) s[m] = q0[m] + q1[m];
#pragma unroll
    for (int m = 0; m < 4; ++m) t[m] = __shfl_xor(s[m], 16);
#pragma unroll
    for (int m = 0; m < 4; ++m) s[m] += t[m];
#pragma unroll
    for (int m = 0; m < 4; ++m) t[m] = __shfl_xor(s[m], 32);
#pragma unroll
    for (int m = 0; m < 4; ++m) ri[m] = __builtin_amdgcn_rsqf((s[m] + t[m]) * (1.0f / 512.0f) + EPS);
}
struct EpiGate {
    static constexpr bool ACC_INIT = false;
    static constexpr bool DUPK = false;
    bf16_t* O; const float* ssq; const float* ossq; const float* gn;
    __device__ __forceinline__ void operator()(const f32x4 (&acc)[2][2][4][2], const Unit& u, int wr, int wc, int fr, int fq, const EpiCtx& ec) const {
        const int row0 = u.pm * BM + wr * 64 + fr, col0 = u.pn * BM + wc * 32 + 8 * fq, head = u.pn >> 1;
        float rsv[2][4], rinv[2][4];
        row_scales_cached(ec, ssq, u.pm, wr, fr, rsv);
        float q0[2][4], q1[2][4];
#pragma unroll
        for (int ai = 0; ai < 2; ++ai)
#pragma unroll
            for (int m = 0; m < 4; ++m) { const float* p = ossq + (size_t)(row0 + ai * HALF + m * 16) * 32 + head * 8 + fq * 2; q0[ai][m] = gld<float>(p); q1[ai][m] = gld<float>(p + 1); }
        f32x4 gg[2][2];
#pragma unroll
        for (int bj = 0; bj < 2; ++bj) { gg[bj][0] = gld<f32x4>(gn + col0 + bj * HALF); gg[bj][1] = gld<f32x4>(gn + col0 + bj * HALF + 4); }
        u32x4 ov[2][2][2];
#define GATE_LOAD(buf, b) do { _Pragma("unroll") for (int mm = 0; mm < 2; ++mm) _Pragma("unroll") for (int bj = 0; bj < 2; ++bj) \
            ov[buf][mm][bj] = gld<u32x4>(O + (size_t)(row0 + ((b) >> 1) * HALF + (2 * ((b) & 1) + mm) * 16) * 2048 + col0 + bj * HALF); } while (0)
        GATE_LOAD(0, 0);
        {
            float s[2][4], t[2][4];
#pragma unroll
            for (int ai = 0; ai < 2; ++ai)
#pragma unroll
                for (int m = 0; m < 4; ++m) s[ai][m] = q0[ai][m] + q1[ai][m];
#pragma unroll
            for (int ai = 0; ai < 2; ++ai)
#pragma unroll
                for (int m = 0; m < 4; ++m) t[ai][m] = __shfl_xor(s[ai][m], 16);
#pragma unroll
            for (int ai = 0; ai < 2; ++ai)
#pragma unroll
                for (int m = 0; m < 4; ++m) s[ai][m] += t[ai][m];
#pragma unroll
            for (int ai = 0; ai < 2; ++ai)
#pragma unroll
                for (int m = 0; m < 4; ++m) t[ai][m] = __shfl_xor(s[ai][m], 32);
#pragma unroll
            for (int ai = 0; ai < 2; ++ai)
#pragma unroll
                for (int m = 0; m < 4; ++m) rinv[ai][m] = __builtin_amdgcn_rsqf((s[ai][m] + t[ai][m]) * (1.0f / 512.0f) + EPS);
        }
        GATE_LOAD(1, 1);
#pragma unroll
        for (int b = 0; b < 4; ++b) {
            const int ai = b >> 1;
#pragma unroll
            for (int mm = 0; mm < 2; ++mm) {
                const int m = 2 * (b & 1) + mm, r = row0 + ai * HALF + m * 16; const float rs = rsv[ai][m], ri = rinv[ai][m];
#pragma unroll
                for (int bj = 0; bj < 2; ++bj) {
                    const u32x4 o = ov[b & 1][mm][bj];
                    const f32x4 g0 = gg[bj][0] * ri, g1 = gg[bj][1] * ri;
                    const f32x4 a0 = acc[ai][bj][m][0] * rs, a1 = acc[ai][bj][m][1] * rs;
                    u32x4 w;
                    w.x = cvt_pk_bf16(bf_lo(o.x) * g0[0] * silu_f(a0[0]), bf_hi(o.x) * g0[1] * silu_f(a0[1]));
                    w.y = cvt_pk_bf16(bf_lo(o.y) * g0[2] * silu_f(a0[2]), bf_hi(o.y) * g0[3] * silu_f(a0[3]));
                    w.z = cvt_pk_bf16(bf_lo(o.z) * g1[0] * silu_f(a1[0]), bf_hi(o.z) * g1[1] * silu_f(a1[1]));
                    w.w = cvt_pk_bf16(bf_lo(o.w) * g1[2] * silu_f(a1[2]), bf_hi(o.w) * g1[3] * silu_f(a1[3]));
                    gst<u32x4>(O + (size_t)r * 2048 + col0 + bj * HALF, w); }
            }
            if (b < 2) GATE_LOAD(b & 1, b + 2);
        }
#undef GATE_LOAD
    }
};

template <class Epi>
__device__ __forceinline__ void gemm_phase(const Ctx cx, LAS uchar* lds, const Gemm g, const StaticOrder& S, const Epi& E) {
    const int tid = cx.tid, wid = __builtin_amdgcn_readfirstlane(tid >> 6), lane = tid & 63, wr = wid >> 2, wc = wid & 3, fr = lane & 15, fq = lane >> 4;
    const int K = g.K, nt = K / BK;
    unsigned voffA[2], voffB[2];
#pragma unroll
    for (int i = 0; i < 2; ++i) { int R, C; stage_rc(tid * 16 + i * 8192, R, C); const int Rb = (R & ~31) + perm32(R & 31);
        voffA[i] = (unsigned)(R * g.lda + C) * 2u; voffB[i] = (unsigned)(Rb * g.ldb + C) * 2u; }
    const size_t kstep = (size_t)(BK * 2);
    const size_t hstepA = (size_t)HALF * g.lda * 2, hstepB = (size_t)HALF * g.ldb * 2;
    const size_t tstepA = 2 * hstepA, tstepB = 2 * hstepB;
    const unsigned ldsw = (unsigned)wid * 1024u;
    const int aoff = lds_byte(wr * 64 + fr, fq * 8), boff = lds_byte(wc * 32 + fr, fq * 8);
#define PG8_SA(b, h) (((b) * 2 + (h)) * HTB)
#define PG8_SB(b, h) ((4 + (b) * 2 + (h)) * HTB)
#define PG8_STAGE(bufoff, gbase, voff) do { const char* _gb = (const char*)(gbase); asm volatile("" : "+s"(_gb));   \
    _Pragma("unroll") for (int _i = 0; _i < 2; ++_i) { asm volatile("" : "+v"((voff)[_i]));   \
        __builtin_amdgcn_global_load_lds((const unsigned*)(_gb + (voff)[_i]), (LAS unsigned*)(lds + (bufoff) + ldsw + _i * 8192), 16, 0, 0); } } while (0)
#define PG8_LDA(dst, b, h) do { _Pragma("unroll") for (int m = 0; m < 4; ++m) _Pragma("unroll") for (int k = 0; k < 2; ++k) dst[m][k] = *(const LAS bf16x8*)(lds + PG8_SA(b, h) + aoff + m * 2048 + k * 1024); } while (0)
#define PG8_LDB(dst, b, h) do { _Pragma("unroll") for (int n = 0; n < 2; ++n) _Pragma("unroll") for (int k = 0; k < 2; ++k) dst[n][k] = *(const LAS bf16x8*)(lds + PG8_SB(b, h) + boff + n * 2048 + k * 1024); } while (0)
#define PG8_MMA(ai, bj, At, Bt) do { __builtin_amdgcn_s_setprio(3); _Pragma("unroll") for (int m = 0; m < 4; ++m) _Pragma("unroll") for (int n = 0; n < 2; ++n) _Pragma("unroll") for (int k = 0; k < 2; ++k) \
        acc[ai][bj][m][n] = __builtin_amdgcn_mfma_f32_16x16x32_bf16(Bt[n][k], At[m][k], acc[ai][bj][m][n], 0, 0, 0); __builtin_amdgcn_s_setprio(0); } while (0)
#define PG8_WAIT_V(n) asm volatile("s_waitcnt vmcnt(" #n ")" ::: "memory")
#define PG8_WAIT_L(n) asm volatile("s_waitcnt lgkmcnt(" #n ")" ::: "memory")
#define PG8_BAR __builtin_amdgcn_s_barrier()
#define PG8_SCHED __builtin_amdgcn_sched_barrier(0)
    Unit cur, nxt; int ui = 0; int prev_pm = -1;
    if (!S.next(0, cur)) return;
    f32x4 acc[2][2][4][2];
#pragma unroll
    for (int a = 0; a < 2; ++a)
#pragma unroll
        for (int b = 0; b < 2; ++b)
#pragma unroll
            for (int m = 0; m < 4; ++m)
#pragma unroll
                for (int n = 0; n < 2; ++n) acc[a][b][m][n] = (f32x4){0.f, 0.f, 0.f, 0.f};
    bf16x8 At[4][2], B0[2][2], B1[2][2];
    const char* cA = (const char*)g.A + (size_t)cur.pm * tstepA; const char* cB = (const char*)g.Bt + (size_t)cur.pn * tstepB;
    PG8_STAGE(PG8_SB(0, 0), cB, voffB); PG8_STAGE(PG8_SA(0, 0), cA, voffA); PG8_STAGE(PG8_SB(0, 1), cB + hstepB, voffB); PG8_STAGE(PG8_SA(0, 1), cA + hstepA, voffA);
    if (wr == 1) PG8_BAR;
    PG8_WAIT_V(4); PG8_BAR;
    PG8_STAGE(PG8_SB(1, 0), cB + kstep, voffB); PG8_STAGE(PG8_SA(1, 0), cA + kstep, voffA); PG8_STAGE(PG8_SB(1, 1), cB + hstepB + kstep, voffB);
    PG8_WAIT_V(6); PG8_BAR;
    for (;;) {
        const bool has_next = S.next(ui + 1, nxt);
        const char* nA = has_next ? (const char*)g.A + (size_t)nxt.pm * tstepA : cA; const char* nB = has_next ? (const char*)g.Bt + (size_t)nxt.pn * tstepB : cB;
        for (int tt = 0; tt < (Epi::DUPK ? 2 : 1) * nt; tt += 2) {
            const int t = tt < nt ? tt : tt - nt;
            const bool last = (tt == (Epi::DUPK ? 2 : 1) * nt - 2);
            const int t2 = (t + 2 == nt) ? 0 : t + 2;
            const char* a1 = cA + (size_t)(t + 1) * kstep;
            const char* a2 = last ? nA : cA + (size_t)t2 * kstep; const char* b2 = last ? nB : cB + (size_t)t2 * kstep;
            const char* a3 = a2 + kstep; const char* b3 = b2 + kstep;
            PG8_LDB(B0, 0, 0); PG8_SCHED; PG8_LDA(At, 0, 0); PG8_STAGE(PG8_SA(1, 1), a1 + hstepA, voffA);
            PG8_WAIT_L(8); PG8_BAR; PG8_WAIT_L(0); PG8_MMA(0, 0, At, B0); PG8_BAR; PG8_SCHED;
            PG8_LDB(B1, 0, 1); PG8_STAGE(PG8_SB(0, 0), b2, voffB);
            PG8_BAR; PG8_WAIT_L(0); PG8_MMA(0, 1, At, B1); PG8_BAR;
            PG8_LDA(At, 0, 1); PG8_STAGE(PG8_SA(0, 0), a2, voffA);
            PG8_BAR; PG8_WAIT_L(0); PG8_MMA(1, 0, At, B0); PG8_BAR; PG8_SCHED;
            PG8_STAGE(PG8_SB(0, 1), b2 + hstepB, voffB);
            PG8_WAIT_V(6); PG8_BAR; PG8_MMA(1, 1, At, B1); PG8_BAR;
            PG8_LDB(B0, 1, 0); PG8_SCHED; PG8_LDA(At, 1, 0); PG8_STAGE(PG8_SA(0, 1), a2 + hstepA, voffA);
            PG8_WAIT_L(8); PG8_BAR; PG8_WAIT_L(0); PG8_MMA(0, 0, At, B0); PG8_BAR; PG8_SCHED;
            PG8_LDB(B1, 1, 1); PG8_STAGE(PG8_SB(1, 0), b3, voffB);
            PG8_BAR; PG8_WAIT_L(0); PG8_MMA(0, 1, At, B1); PG8_BAR;
            PG8_LDA(At, 1, 1); PG8_STAGE(PG8_SA(1, 0), a3, voffA);
            PG8_BAR; PG8_WAIT_L(0); PG8_MMA(1, 0, At, B0); PG8_BAR; PG8_SCHED;
            PG8_STAGE(PG8_SB(1, 1), b3 + hstepB, voffB);
            PG8_WAIT_V(6); PG8_BAR; PG8_MMA(1, 1, At, B1); PG8_BAR;
        }
        {
            int fr_e = fr, fq_e = fq; asm volatile("" : "+v"(fr_e), "+v"(fq_e));
            EpiCtx ec; ec.lds = lds; ec.wid = wid; ec.lane = fr_e + 16 * fq_e; ec.pm_fresh = (cur.pm != prev_pm); prev_pm = cur.pm;
            E(acc, cur, wr, wc, fr_e, fq_e, ec);
        }
        if (!has_next) break;
#pragma unroll
        for (int a = 0; a < 2; ++a)
#pragma unroll
            for (int b = 0; b < 2; ++b)
#pragma unroll
                for (int m = 0; m < 4; ++m)
#pragma unroll
                    for (int n = 0; n < 2; ++n) acc[a][b][m][n] = (f32x4){0.f, 0.f, 0.f, 0.f};
        cur = nxt; cA = nA; cB = nB; ++ui;
    }
    PG8_WAIT_V(0);
    if (wr == 0) PG8_BAR;
    PG8_BAR;
#undef PG8_SA
#undef PG8_SB
#undef PG8_STAGE
#undef PG8_LDA
#undef PG8_LDB
#undef PG8_MMA
#undef PG8_WAIT_V
#undef PG8_WAIT_L
#undef PG8_BAR
#undef PG8_SCHED
}

struct Args {
    const float* x; const int* pos; const float* mix_g; const float* ffn_g; const float* fin_g;
    const float* sgu_w_in; const float* sgu_w_s; const float* sgu_b_s; const float* sgu_ln_g; const float* sgu_ln_b; const float* sgu_w_out;
    const float* ret_w_in; const float* ret_gn_g; const float* ret_w_out; const float* ffn_w_gu; const float* ffn_w_down;
    float* out; uchar* ws; int ph_lo, ph_hi;
};

struct TileJob { const float* W; bf16_t* Wt; const float* gain; int K, N, tk, src0, n0; };
__device__ __forceinline__ TileJob decode_tile(const Args& a, uchar* ws, int tile) {
    TileJob t; int r, mode = 0, ntk;
    if (tile < 5632) {
        const int j = tile / 2816; r = tile - j * 2816;
        if (r < 512)       { t.W = a.sgu_w_in + (size_t)j * 1024 * 2048; t.Wt = (bf16_t*)(ws + WS_SGU_IN) + (size_t)j * 2048 * 1024; t.gain = a.mix_g + (2 * j) * 1024; t.K = 1024; t.N = 2048; }
        else if (r < 768)  { r -= 512;  t.W = a.sgu_w_out + (size_t)j * 1024 * 1024; t.Wt = (bf16_t*)(ws + WS_SGU_OUT) + (size_t)j * 1024 * 1024; t.gain = nullptr; t.K = 1024; t.N = 1024; }
        else if (r < 2304) { r -= 768;  t.W = a.ret_w_in + (size_t)j * 1024 * 6144; t.Wt = (bf16_t*)(ws + WS_RET_IN) + (size_t)j * 6144 * 1024; t.gain = a.mix_g + (2 * j + 1) * 1024; t.K = 1024; t.N = 6144; }
        else               { r -= 2304; t.W = a.ret_w_out + (size_t)j * 2048 * 1024; t.Wt = (bf16_t*)(ws + WS_RET_OUT) + (size_t)j * 1024 * 2048; t.gain = nullptr; t.K = 2048; t.N = 1024; }
    } else {
        const int t2 = tile - 5632, i = t2 / 2112; r = t2 - i * 2112;
        if (r < 1408) { t.W = a.ffn_w_gu + (size_t)i * 1024 * 5632; t.Wt = (bf16_t*)(ws + WS_GU) + (size_t)i * 5632 * 1024; t.gain = a.ffn_g + i * 1024; t.K = 1024; t.N = 5632; mode = 1; }
        else          { r -= 1408; t.W = a.ffn_w_down + (size_t)i * FF * 1024; t.Wt = (bf16_t*)(ws + WS_DOWN) + (size_t)i * 1024 * FF; t.gain = nullptr; t.K = FF; t.N = 1024; }
    }
    ntk = t.K / 64; t.tk = r % ntk; t.n0 = (r / ntk) * 64; t.src0 = t.n0;
    if (mode == 1) { const int tt = t.n0 >> 8, half = (t.n0 >> 7) & 1, jj = t.n0 & 127; t.src0 = half * FF + tt * 128 + jj; }
    return t;
}
constexpr int N_WTILES = 5632 + 8448;

__device__ __forceinline__ void x_row_finish(const f32x4 (&v)[4], int r, int lane, bf16_t* HB, float* ssq) {
    float q = 0.f;
#pragma unroll
    for (int i = 0; i < 4; ++i) {
        const int c = i * 256 + lane * 4;
        u32x2 w; w.x = cvt_pk_bf16(v[i][0], v[i][1]); w.y = cvt_pk_bf16(v[i][2], v[i][3]);
        gst<u32x2>(HB + (size_t)r * DM + c, w);
        q += (bf_lo(w.x) * bf_lo(w.x) + bf_hi(w.x) * bf_hi(w.x)) + (bf_lo(w.y) * bf_lo(w.y) + bf_hi(w.y) * bf_hi(w.y));
    }
#pragma unroll
    for (int o = 32; o >= 1; o >>= 1) q += __shfl_xor(q, o);
    if (lane < 16) gst<float>(ssq + (size_t)r * 16 + lane, (lane == 0) ? q : 0.f);
}

__device__ __forceinline__ void prep_phase(const Ctx cx, LAS uchar* lds, const Args& a) {
    LAS float* tile = (LAS float*)lds;
    uchar* ws = a.ws;
    bf16_t* HB = (bf16_t*)(ws + WS_HB); float* ssq = (float*)(ws + WS_SSQ);
    const int lane = cx.tid & 63, gw = cx.bid * 8 + (cx.tid >> 6), nw = cx.nblk * 8;
    int xr = gw;
    {
        const int tid = cx.tid, kl = tid >> 4, nl4 = (tid & 15) * 4, nl = tid >> 3, kc = (tid & 7) * 8;
        f32x4 v[2]; float gsc[2]; f32x4 xv[4];
        int cur = cx.bid;
        TileJob tj = decode_tile(a, ws, cur < N_WTILES ? cur : 0);
#pragma unroll
        for (int pass = 0; pass < 2; ++pass) { const int k = tj.tk * 64 + pass * 32 + kl; v[pass] = gld<f32x4>(tj.W + (size_t)k * tj.N + tj.src0 + nl4); gsc[pass] = tj.gain ? gld<float>(tj.gain + k) : 1.0f; }
        if (xr < M_TOK) {
#pragma unroll
            for (int i = 0; i < 4; ++i) xv[i] = gld<f32x4>(a.x + (size_t)xr * DM + i * 256 + lane * 4);
        }
        for (; cur < N_WTILES; cur += cx.nblk) {
#pragma unroll
            for (int pass = 0; pass < 2; ++pass) {
                LAS float* tp = tile + (pass * 32 + kl) * 65 + nl4;
                tp[0] = v[pass][0] * gsc[pass]; tp[1] = v[pass][1] * gsc[pass]; tp[2] = v[pass][2] * gsc[pass]; tp[3] = v[pass][3] * gsc[pass];
            }
            __syncthreads();
            const TileJob tc = tj;
            const int nxt = cur + cx.nblk;
            if (nxt < N_WTILES) {
                tj = decode_tile(a, ws, nxt);
#pragma unroll
                for (int pass = 0; pass < 2; ++pass) { const int k = tj.tk * 64 + pass * 32 + kl; v[pass] = gld<f32x4>(tj.W + (size_t)k * tj.N + tj.src0 + nl4); gsc[pass] = tj.gain ? gld<float>(tj.gain + k) : 1.0f; }
            }
            float e[8];
#pragma unroll
            for (int i = 0; i < 8; ++i) e[i] = tile[(kc + i) * 65 + nl];
            u32x4 w; w.x = cvt_pk_bf16(e[0], e[1]); w.y = cvt_pk_bf16(e[2], e[3]); w.z = cvt_pk_bf16(e[4], e[5]); w.w = cvt_pk_bf16(e[6], e[7]);
            gst<u32x4>(tc.Wt + (size_t)(tc.n0 + nl) * tc.K + tc.tk * 64 + kc, w);
            if (xr < M_TOK) {
                x_row_finish(xv, xr, lane, HB, ssq);
                xr += nw;
                if (xr < M_TOK) {
#pragma unroll
                    for (int i = 0; i < 4; ++i) xv[i] = gld<f32x4>(a.x + (size_t)xr * DM + i * 256 + lane * 4);
                }
            }
            __syncthreads();
        }
        while (xr < M_TOK) {
            x_row_finish(xv, xr, lane, HB, ssq);
            xr += nw;
            if (xr < M_TOK) {
#pragma unroll
                for (int i = 0; i < 4; ++i) xv[i] = gld<f32x4>(a.x + (size_t)xr * DM + i * 256 + lane * 4);
            }
        }
    }
    {
        bf16_t* wm = (bf16_t*)(ws + WS_WSM);
        const int total = 2 * 8 * 128 * 128;
        for (int i = (cx.bid * 512 + cx.tid) * 2; i < total; i += cx.nblk * 512 * 2) {
            const int s = i & 127, t = (i >> 7) & 127;
            const float v0 = (s <= t) ? gld<float>(a.sgu_w_s + i) : 0.f, v1 = (s + 1 <= t) ? gld<float>(a.sgu_w_s + i + 1) : 0.f;
            gst<unsigned>(wm + i, cvt_pk_bf16(v0, v1));
        }
    }
}

__device__ __forceinline__ void final_phase(const Ctx cx, const Args& a) {
    const int lane = cx.tid & 63, gw = cx.bid * 8 + (cx.tid >> 6), nw = cx.nblk * 8;
    float* H = a.out; const bf16_t* HB = (const bf16_t*)(a.ws + WS_HB); const float* ssq = (const float*)(a.ws + WS_SSQ);
    for (int r = gw; r < M_TOK; r += nw) {
        float s = gld<float>(ssq + (size_t)r * 16 + (lane & 15));
        s += __shfl_xor(s, 1); s += __shfl_xor(s, 2); s += __shfl_xor(s, 4); s += __shfl_xor(s, 8);
        const float rs = rsqrtf(s * (1.0f / 1024.0f) + EPS);
#pragma unroll
        for (int i = 0; i < 4; ++i) {
            const int c = i * 256 + lane * 4;
            const u32x2 hv = gld<u32x2>(HB + (size_t)r * DM + c); const f32x4 g = gld<f32x4>(a.fin_g + c);
            const f32x4 v = (f32x4){bf_lo(hv.x), bf_hi(hv.x), bf_lo(hv.y), bf_hi(hv.y)};
            gst<f32x4>(H + (size_t)r * DM + c, v * rs * g);
        }
    }
}

__device__ __forceinline__ s16x4 tr_read(LAS uchar* p) { return __builtin_amdgcn_ds_read_tr16_b64_v4i16((LAS s16x4*)p); }
__device__ __forceinline__ bf16x8 cat8(s16x4 a, s16x4 b) { return __builtin_shufflevector(a, b, 0, 1, 2, 3, 4, 5, 6, 7); }

__device__ __forceinline__ void sgu_mix_phase(const Ctx cx, LAS uchar* lds, bf16_t* Z, bf16_t* Zout, const bf16_t* Wm, const float* bs, const float* lng, const float* lnb) {
    constexpr int VST = 288;
    LAS float* stats = (LAS float*)lds;
    LAS uchar* vimg = lds + 1024;
    LAS float* lgb = (LAS float*)(lds + 1024 + 128 * VST);
    const int tid = cx.tid, wid = __builtin_amdgcn_readfirstlane(tid >> 6), lane = tid & 63, fr = lane & 15, fq = lane >> 4;
    const int q4 = fr >> 2, p4 = fr & 3;
    __syncthreads();
    for (int i = tid; i < 2048; i += 512) lgb[i] = gld<float>((i < 1024 ? lng : lnb - 1024) + i);
    for (int chunk = cx.bid; chunk < NCHUNK; chunk += cx.nblk) {
        bf16_t* zc = Z + (size_t)chunk * 128 * 2048;
        __syncthreads();
#pragma unroll 1
        for (int i4 = 0; i4 < 4; ++i4) {
            u32x4 ra[4], rb[4];
#pragma unroll
            for (int i = 0; i < 4; ++i) { const bf16_t* p = zc + (size_t)(wid * 16 + i4 * 4 + i) * 2048 + 1024 + lane * 16; ra[i] = gld<u32x4>(p); rb[i] = gld<u32x4>(p + 8); }
            float s[4], q[4];
#pragma unroll
            for (int i = 0; i < 4; ++i) {
                s[i] = 0.f; q[i] = 0.f;
#pragma unroll
                for (int e = 0; e < 4; ++e) { const float x0 = bf_lo(ra[i][e]), x1 = bf_hi(ra[i][e]), x2 = bf_lo(rb[i][e]), x3 = bf_hi(rb[i][e]); s[i] += (x0 + x1) + (x2 + x3); q[i] += (x0 * x0 + x1 * x1) + (x2 * x2 + x3 * x3); }
            }
#pragma unroll
            for (int o = 32; o >= 1; o >>= 1) {
                float ts[4], tq[4];
#pragma unroll
                for (int i = 0; i < 4; ++i) { ts[i] = __shfl_xor(s[i], o); tq[i] = __shfl_xor(q[i], o); }
#pragma unroll
                for (int i = 0; i < 4; ++i) { s[i] += ts[i]; q[i] += tq[i]; }
            }
            if (lane < 4) {
                const float sv = lane == 0 ? s[0] : lane == 1 ? s[1] : lane == 2 ? s[2] : s[3], qv = lane == 0 ? q[0] : lane == 1 ? q[1] : lane == 2 ? q[2] : q[3];
                const float mean = sv * (1.0f / 1024.0f); const float var = qv * (1.0f / 1024.0f) - mean * mean;
                const int row = wid * 16 + i4 * 4 + lane;
                stats[row * 2] = mean; stats[row * 2 + 1] = __builtin_amdgcn_rsqf(fmaxf(var, 0.f) + EPS);
            }
        }
        const int fs = tid >> 2, dseg = (tid & 3) * 32;
        u32x4 raw[4];
#pragma unroll
        for (int i = 0; i < 4; ++i) raw[i] = gld<u32x4>(zc + (size_t)fs * 2048 + 1024 + dseg + i * 8);
#pragma unroll 1
        for (int g = 0; g < 8; ++g) {
            __syncthreads();
            {
                const float mean = stats[fs * 2], rstd = stats[fs * 2 + 1];
#pragma unroll
                for (int i = 0; i < 4; ++i) {
                    const int d = g * 128 + dseg + i * 8;
                    const f32x4 g0 = *(const LAS f32x4*)(lgb + d) * rstd, g1 = *(const LAS f32x4*)(lgb + d + 4) * rstd, b0 = *(const LAS f32x4*)(lgb + 1024 + d), b1 = *(const LAS f32x4*)(lgb + 1024 + d + 4);
                    u32x4 w;
                    w.x = cvt_pk_bf16((bf_lo(raw[i].x) - mean) * g0[0] + b0[0], (bf_hi(raw[i].x) - mean) * g0[1] + b0[1]);
                    w.y = cvt_pk_bf16((bf_lo(raw[i].y) - mean) * g0[2] + b0[2], (bf_hi(raw[i].y) - mean) * g0[3] + b0[3]);
                    w.z = cvt_pk_bf16((bf_lo(raw[i].z) - mean) * g1[0] + b1[0], (bf_hi(raw[i].z) - mean) * g1[1] + b1[1]);
                    w.w = cvt_pk_bf16((bf_lo(raw[i].w) - mean) * g1[2] + b1[2], (bf_hi(raw[i].w) - mean) * g1[3] + b1[3]);
                    *(LAS u32x4*)(vimg + fs * VST + (dseg + i * 8) * 2) = w;
                }
            }
            const int t = 16 * wid + fr;
            bf16x8 wf[4]; u32x2 uu[8];
#pragma unroll
            for (int kk = 0; kk < 4; ++kk) wf[kk] = gld<bf16x8>(Wm + ((size_t)(g * 128 + t)) * 128 + 32 * kk + 8 * fq);
            const size_t ubase = (size_t)chunk * 128 * 2048 + (size_t)t * 2048 + g * 128 + 4 * fq;
#pragma unroll
            for (int nd = 0; nd < 8; ++nd) uu[nd] = gld<u32x2>(Z + ubase + 16 * nd);
            const float bias = gld<float>(bs + g * 128 + t);
            if (g < 7) {
#pragma unroll
                for (int i = 0; i < 4; ++i) raw[i] = gld<u32x4>(zc + (size_t)fs * 2048 + 1024 + (g + 1) * 128 + dseg + i * 8);
            }
            __syncthreads();
            f32x4 acc[8];
#pragma unroll
            for (int nd = 0; nd < 8; ++nd) acc[nd] = (f32x4){0.f, 0.f, 0.f, 0.f};
            const int kkmax = (16 * wid + 15) >> 5;
#pragma unroll
            for (int kk = 0; kk < 4; ++kk) {
                if (kk <= kkmax) {
#pragma unroll
                    for (int nd = 0; nd < 8; ++nd) {
                        LAS uchar* ap = vimg + (32 * kk + 8 * fq + q4) * VST + (16 * nd + 4 * p4) * 2;
                        const bf16x8 vf = cat8(tr_read(ap), tr_read(ap + 4 * VST));
                        acc[nd] = __builtin_amdgcn_mfma_f32_16x16x32_bf16(vf, wf[kk], acc[nd], 0, 0, 0);
                    }
                }
            }
#pragma unroll
            for (int nd = 0; nd < 8; ++nd) {
                u32x2 w; w.x = cvt_pk_bf16(bf_lo(uu[nd].x) * (acc[nd][0] + bias), bf_hi(uu[nd].x) * (acc[nd][1] + bias)); w.y = cvt_pk_bf16(bf_lo(uu[nd].y) * (acc[nd][2] + bias), bf_hi(uu[nd].y) * (acc[nd][3] + bias));
                gst<u32x2>(Zout + ubase + 16 * nd, w);
            }
        }
    }
}

__device__ __forceinline__ void retention_phase(const Ctx cx, LAS uchar* lds, const bf16_t* Q, const bf16_t* Kb, const bf16_t* V, bf16_t* Oout, float* ossq) {
    constexpr int KST = 544, VST = 160, SST = 544;
    LAS uchar* kR = lds;
    LAS uchar* vR = lds + 69632;
    LAS uchar* vS = vR + 20480;
    LAS uchar* ST = vS + 20480;
    const int tid0 = cx.tid, wid = __builtin_amdgcn_readfirstlane(tid0 >> 6);
    const int tw = wid < 4 ? wid : 11 - wid;
    for (int item = cx.bid; item < 256; item += cx.nblk) {
        const int xcd = item & 7, local = item >> 3, pairi = xcd * 4 + (local >> 3);
        const int j = local & 7, h = pairi & 3, b = pairi >> 2;
        const float lg = log2f(1.0f - exp2f(-5.0f - (float)h));
        const float chunk_decay = exp2f(128.0f * lg);
        __syncthreads();
        for (int i = tid0; i < 34816 / 16; i += 512) ((LAS u32x4*)ST)[i] = (u32x4){0u, 0u, 0u, 0u};
        f32x4 accS[2][4];
#pragma unroll
        for (int dl = 0; dl < 2; ++dl)
#pragma unroll
            for (int vt = 0; vt < 4; ++vt) accS[dl][vt] = (f32x4){0.f, 0.f, 0.f, 0.f};
        u32x4 kreg[8]; u32x4 vreg[2]; bf16x8 qn[8];
        const float rowfac = __builtin_amdgcn_exp2f((float)(16 * tw + (tid0 & 15)) * lg), g16i = __builtin_amdgcn_exp2f(-16.0f * lg);
        float colfac[4];
#pragma unroll
        for (int jj = 0; jj < 4; ++jj) colfac[jj] = __builtin_amdgcn_exp2f(-(float)(4 * ((tid0 & 63) >> 4) + jj) * lg);
        {
            const size_t r0 = (size_t)b * SEQ;
            const int lane = tid0 & 63, fr = lane & 15, fq = lane >> 4;
#pragma unroll
            for (int i = 0; i < 8; ++i) { const int idx = tid0 + 512 * i, s = idx >> 5, ch = idx & 31; kreg[i] = gld<u32x4>(Kb + (r0 + s) * DM + h * 256 + ch * 8); }
            { const int s = tid0 >> 2, c16 = (tid0 & 3) * 16; const bf16_t* vp = V + (r0 + s) * 2048 + h * 512 + j * 64 + c16; vreg[0] = gld<u32x4>(vp); vreg[1] = gld<u32x4>(vp + 8); }
#pragma unroll
            for (int kk = 0; kk < 8; ++kk) qn[kk] = gld<bf16x8>(Q + (r0 + 16 * tw + fr) * DM + h * 256 + 32 * kk + 8 * fq);
        }
        for (int c = 0; c < 64; ++c) {
            const size_t r0 = (size_t)b * SEQ + (size_t)c * 128;
            int tid = tid0; asm volatile("" : "+v"(tid));
            const int lane = tid & 63, fr = lane & 15, fq = lane >> 4, q4 = fr >> 2, p4 = fr & 3;
            bf16x8 qf[8];
            __syncthreads();
#pragma unroll
            for (int i = 0; i < 8; ++i) { const int idx = tid + 512 * i, s = idx >> 5, ch = idx & 31; *(LAS u32x4*)(kR + s * KST + ch * 16) = kreg[i]; }
            {
                const int s = tid >> 2, c16 = (tid & 3) * 16; const float sd = __builtin_amdgcn_exp2f((float)(127 - s) * lg);
#pragma unroll
                for (int i = 0; i < 2; ++i) {
                    *(LAS u32x4*)(vR + s * VST + c16 * 2 + i * 16) = vreg[i];
                    u32x4 w;
                    w.x = cvt_pk_bf16(bf_lo(vreg[i].x) * sd, bf_hi(vreg[i].x) * sd); w.y = cvt_pk_bf16(bf_lo(vreg[i].y) * sd, bf_hi(vreg[i].y) * sd);
                    w.z = cvt_pk_bf16(bf_lo(vreg[i].z) * sd, bf_hi(vreg[i].z) * sd); w.w = cvt_pk_bf16(bf_lo(vreg[i].w) * sd, bf_hi(vreg[i].w) * sd);
                    *(LAS u32x4*)(vS + s * VST + c16 * 2 + i * 16) = w;
                }
            }
#pragma unroll
            for (int kk = 0; kk < 8; ++kk) qf[kk] = qn[kk];
            if (c > 0) {
#pragma unroll
                for (int dl = 0; dl < 2; ++dl)
#pragma unroll
                    for (int vt = 0; vt < 4; ++vt) {
                        u32x2 w; w.x = cvt_pk_bf16(accS[dl][vt][0], accS[dl][vt][1]); w.y = cvt_pk_bf16(accS[dl][vt][2], accS[dl][vt][3]);
                        *(LAS u32x2*)(ST + (16 * vt + fr) * SST + (16 * (2 * wid + dl) + 4 * fq) * 2) = w;
                    }
            }
            __syncthreads();
            {
                const size_t rn = (size_t)b * SEQ + (size_t)(c < 63 ? c + 1 : 63) * 128;
#pragma unroll
                for (int i = 0; i < 8; ++i) { const int idx = tid + 512 * i, s = idx >> 5, ch = idx & 31; kreg[i] = gld<u32x4>(Kb + (rn + s) * DM + h * 256 + ch * 8); }
                { const int s = tid >> 2, c16 = (tid & 3) * 16; const bf16_t* vp = V + (rn + s) * 2048 + h * 512 + j * 64 + c16; vreg[0] = gld<u32x4>(vp); vreg[1] = gld<u32x4>(vp + 8); }
            }
            f32x4 accX[4], accI[4];
#pragma unroll
            for (int vt = 0; vt < 4; ++vt) { accX[vt] = (f32x4){0.f, 0.f, 0.f, 0.f}; accI[vt] = (f32x4){0.f, 0.f, 0.f, 0.f}; }
            {
                bf16x8 sa[8];
#pragma unroll
                for (int i = 0; i < 8; ++i) sa[i] = *(const LAS bf16x8*)(ST + (16 * (i & 3) + fr) * SST + (32 * (i >> 2) + 8 * fq) * 2);
#pragma unroll
                for (int r = 0; r < 4; ++r) {
                    __builtin_amdgcn_sched_barrier(0);
                    __builtin_amdgcn_s_setprio(3);
#pragma unroll
                    for (int i = 0; i < 8; ++i) accX[i & 3] = __builtin_amdgcn_mfma_f32_16x16x32_bf16(sa[i], qf[2 * r + (i >> 2)], accX[i & 3], 0, 0, 0);
                    __builtin_amdgcn_s_setprio(0);
                    __builtin_amdgcn_sched_barrier(0);
                    if (r < 3) {
#pragma unroll
                        for (int i = 0; i < 8; ++i) sa[i] = *(const LAS bf16x8*)(ST + (16 * (i & 3) + fr) * SST + (32 * (2 * (r + 1) + (i >> 2)) + 8 * fq) * 2);
                    }
                }
            }
            const int t_in = 16 * tw + fr;
#pragma unroll
            for (int kk2 = 0; kk2 < 4; ++kk2) {
                if (kk2 <= (tw >> 1)) {
                    f32x4 accP0 = (f32x4){0.f, 0.f, 0.f, 0.f}, accP1 = (f32x4){0.f, 0.f, 0.f, 0.f};
#pragma unroll
                    for (int kh = 0; kh < 2; ++kh) {
                        bf16x8 af0[4], af1[4];
#pragma unroll
                        for (int k4 = 0; k4 < 4; ++k4) {
                            af0[k4] = *(const LAS bf16x8*)(kR + (32 * kk2 + fr) * KST + (32 * (4 * kh + k4) + 8 * fq) * 2);
                            af1[k4] = *(const LAS bf16x8*)(kR + (32 * kk2 + 16 + fr) * KST + (32 * (4 * kh + k4) + 8 * fq) * 2);
                        }
                        __builtin_amdgcn_sched_barrier(0);
                        __builtin_amdgcn_s_setprio(3);
#pragma unroll
                        for (int k4 = 0; k4 < 4; ++k4) {
                            accP0 = __builtin_amdgcn_mfma_f32_16x16x32_bf16(af0[k4], qf[4 * kh + k4], accP0, 0, 0, 0);
                            accP1 = __builtin_amdgcn_mfma_f32_16x16x32_bf16(af1[k4], qf[4 * kh + k4], accP1, 0, 0, 0);
                        }
                        __builtin_amdgcn_s_setprio(0);
                    }
                    float pv[8];
                    float rf = rowfac; asm volatile("" : "+v"(rf));
                    const float f0 = rf * __builtin_amdgcn_exp2f(-32.0f * (float)kk2 * lg), f1 = f0 * g16i;
#pragma unroll
                    for (int jj = 0; jj < 4; ++jj) { pv[jj] = accP0[jj] * (f0 * colfac[jj]); pv[4 + jj] = accP1[jj] * (f1 * colfac[jj]); }
                    if (kk2 == (tw >> 1)) {
#pragma unroll
                        for (int jj = 0; jj < 4; ++jj) {
                            const int d0 = t_in - (32 * kk2 + 4 * fq + jj);
                            pv[jj] = d0 >= 0 ? pv[jj] : 0.f; pv[4 + jj] = d0 >= 16 ? pv[4 + jj] : 0.f;
                        }
                    }
                    u32x4 pw; pw.x = cvt_pk_bf16(pv[0], pv[1]); pw.y = cvt_pk_bf16(pv[2], pv[3]); pw.z = cvt_pk_bf16(pv[4], pv[5]); pw.w = cvt_pk_bf16(pv[6], pv[7]);
                    const bf16x8 pf = __builtin_bit_cast(bf16x8, pw);
#pragma unroll
                    for (int vt = 0; vt < 4; ++vt) {
                        LAS uchar* ap = vR + (32 * kk2 + 4 * fq + q4) * VST + (16 * vt + 4 * p4) * 2;
                        const bf16x8 vf = cat8(tr_read(ap), tr_read(ap + 16 * VST));
                        accI[vt] = __builtin_amdgcn_mfma_f32_16x16x32_bf16(vf, pf, accI[vt], 0, 0, 0);
                    }
                }
            }
            {
                const size_t rn = (size_t)b * SEQ + (size_t)(c < 63 ? c + 1 : 63) * 128;
#pragma unroll
                for (int kk = 0; kk < 8; ++kk) qn[kk] = gld<bf16x8>(Q + (rn + 16 * tw + fr) * DM + h * 256 + 32 * kk + 8 * fq);
            }
            {
                const float cd = __builtin_amdgcn_exp2f((float)(t_in + 1) * lg);
                float q = 0.f;
                bf16_t* op = Oout + (r0 + t_in) * 2048 + h * 512 + j * 64 + 4 * fq;
#pragma unroll
                for (int vt = 0; vt < 4; ++vt) {
                    const f32x4 o = accI[vt] + accX[vt] * cd;
                    q += (o[0] * o[0] + o[1] * o[1]) + (o[2] * o[2] + o[3] * o[3]);
                    u32x2 w; w.x = cvt_pk_bf16(o[0], o[1]); w.y = cvt_pk_bf16(o[2], o[3]);
                    gst<u32x2>(op + 16 * vt, w);
                }
                q += __shfl_xor(q, 16); q += __shfl_xor(q, 32);
                if (fq == 0) gst<float>(ossq + (r0 + t_in) * 32 + h * 8 + j, q);
            }
#pragma unroll
            for (int dl = 0; dl < 2; ++dl)
#pragma unroll
                for (int vt = 0; vt < 4; ++vt) accS[dl][vt] = accS[dl][vt] * chunk_decay;
            {
                bf16x8 vf[2][4], kf[2][2];
#define RET_LOAD_STATE_OPS(buf, kk2) do { \
                    _Pragma("unroll") for (int vt = 0; vt < 4; ++vt) { LAS uchar* bp = vS + (32 * (kk2) + 4 * fq + q4) * VST + (16 * vt + 4 * p4) * 2; vf[buf][vt] = cat8(tr_read(bp), tr_read(bp + 16 * VST)); } \
                    _Pragma("unroll") for (int dl = 0; dl < 2; ++dl) { LAS uchar* ap = kR + (32 * (kk2) + 4 * fq + q4) * KST + (16 * (2 * wid + dl) + 4 * p4) * 2; kf[buf][dl] = cat8(tr_read(ap), tr_read(ap + 16 * KST)); } } while (0)
                RET_LOAD_STATE_OPS(0, 0);
#pragma unroll
                for (int kk2 = 0; kk2 < 4; ++kk2) {
                    if (kk2 < 3) RET_LOAD_STATE_OPS((kk2 + 1) & 1, kk2 + 1);
                    __builtin_amdgcn_sched_barrier(0);
                    __builtin_amdgcn_s_setprio(3);
#pragma unroll
                    for (int dl = 0; dl < 2; ++dl)
#pragma unroll
                        for (int vt = 0; vt < 4; ++vt) accS[dl][vt] = __builtin_amdgcn_mfma_f32_16x16x32_bf16(kf[kk2 & 1][dl], vf[kk2 & 1][vt], accS[dl][vt], 0, 0, 0);
                    __builtin_amdgcn_s_setprio(0);
                    __builtin_amdgcn_sched_barrier(0);
                }
#undef RET_LOAD_STATE_OPS
            }
        }
    }
}

#define XB_TMO      128
#define XB_XCNT(j)  (256  + 64 * (j))
#define XB_XSUB(j)  (1280 + 64 * (j))
#define XB_XGEN(j)  (2304 + 64 * (j))
#define XB_TOP      3328
#define XB_TOPGEN   3392
#define XCD_BAR_WORDS 3456
#define XB_SPIN_CAP (1u << 22)
__device__ __forceinline__ unsigned xb_ld(unsigned* p)              { return __hip_atomic_load(p, __ATOMIC_RELAXED, __HIP_MEMORY_SCOPE_AGENT); }
__device__ __forceinline__ unsigned xb_add(unsigned* p, unsigned v) { return __hip_atomic_fetch_add(p, v, __ATOMIC_RELAXED, __HIP_MEMORY_SCOPE_AGENT); }
__device__ __forceinline__ unsigned xb_xcc_id() { return (unsigned)__builtin_amdgcn_s_getreg((3 << 11) | 20) & 0xFu; }
#define XB_SPIN(cond, bar) do { unsigned _sp = 0; while (cond) { __builtin_amdgcn_s_sleep(1); \
    if ((++_sp & 255u) == 0u) { if (xb_ld(&(bar)[XB_TMO])) break; if (_sp > XB_SPIN_CAP) { atomicAdd(&(bar)[XB_TMO], 1u); break; } } } } while (0)
struct XcdBarrier { unsigned* bar; unsigned x; volatile LAS unsigned* st; };
__device__ __forceinline__ XcdBarrier xcd_barrier_post(unsigned* bar, volatile LAS unsigned* st) {
    XcdBarrier b; b.bar = bar; b.x = xb_xcc_id(); b.st = st;
    if (threadIdx.x == 0) (void)xb_add(&bar[XB_XCNT(b.x)], 1u);
    return b;
}
__device__ __forceinline__ void xcd_barrier_complete(unsigned* bar, unsigned x, unsigned& nloc, unsigned& nx) {
    const unsigned G = gridDim.x * gridDim.y * gridDim.z;
    unsigned sum, cnt, mine, sp = 0u;
    for (;;) {
        sum = 0u; cnt = 0u; mine = 0u;
#pragma unroll
        for (unsigned j = 0; j < 16; ++j) { const unsigned c = xb_ld(&bar[XB_XCNT(j)]); sum += c; cnt += (c > 0u) ? 1u : 0u; mine = (j == x) ? c : mine; }
        if (sum == G) break;
        __builtin_amdgcn_s_sleep(1);
        if ((++sp & 255u) == 0u) { if (xb_ld(&bar[XB_TMO])) break; if (sp > XB_SPIN_CAP) { atomicAdd(&bar[XB_TMO], 1u); break; } }
    }
    nloc = mine > 0u ? mine : 1u; nx = cnt > 0u ? cnt : 1u;
}
__device__ __forceinline__ void xcd_barrier(const XcdBarrier& b) {
    asm volatile("s_waitcnt vmcnt(0)" ::: "memory");
    __syncthreads();
    if (threadIdx.x == 0) {
        unsigned* bar = b.bar;
        __builtin_amdgcn_s_waitcnt(0);
        unsigned nloc = b.st[0], nx = b.st[1];
        if (nloc == 0u) { xcd_barrier_complete(bar, b.x, nloc, nx); b.st[0] = nloc; b.st[1] = nx; }
        const unsigned old = xb_add(&bar[XB_XSUB(b.x)], 1u);
        const unsigned gen = old / nloc;
        if (old + 1u == (gen + 1u) * nloc) {
            __builtin_amdgcn_fence(__ATOMIC_RELEASE, "agent");
            asm volatile("s_waitcnt vmcnt(0)" ::: "memory");
            const unsigned og = xb_add(&bar[XB_TOP], 1u);
            const unsigned tg = og / nx;
            if (og + 1u == (tg + 1u) * nx) xb_add(&bar[XB_TOPGEN], 1u);
            else XB_SPIN(xb_ld(&bar[XB_TOPGEN]) == tg, bar);
            __builtin_amdgcn_fence(__ATOMIC_ACQUIRE, "agent");
            xb_add(&bar[XB_XGEN(b.x)], 1u);
            asm volatile("s_waitcnt vmcnt(0)" ::: "memory");
        } else {
            XB_SPIN(xb_ld(&bar[XB_XGEN(b.x)]) == gen, bar);
            __builtin_amdgcn_fence(__ATOMIC_ACQUIRE, "agent");
            asm volatile("s_waitcnt vmcnt(0)" ::: "memory");
        }
    }
    __syncthreads();
}

__global__ void __launch_bounds__(512, 2) mega_fwd(Args a_kernarg) {
#if defined(__HIP_DEVICE_COMPILE__)
    typedef const __attribute__((address_space(4))) Args* KArgs;
    KArgs kap = (KArgs)__builtin_amdgcn_kernarg_segment_ptr();
    const int ph_lo = a_kernarg.ph_lo, ph_hi = a_kernarg.ph_hi;
    extern __shared__ __attribute__((aligned(16))) uchar shm[];
    LAS uchar* lds = (LAS uchar*)shm;
    XcdBarrier bar; bar.bar = nullptr; bar.x = 0; bar.st = (volatile LAS unsigned*)(lds + LDS_MAIN);
    if (ph_hi - ph_lo > 1) {
        if (threadIdx.x < 4) bar.st[threadIdx.x] = 0u;
        __syncthreads();
        bar = xcd_barrier_post((unsigned*)(a_kernarg.ws + WS_BAR), bar.st);
    }
    int probe_rep = 0; (void)probe_rep;
    for (int ph = ph_lo; ph < ph_hi; ++ph) {
        KArgs kapl = kap; asm volatile("" : "+s"(kapl));
        const Args a = *kapl;
        Ctx cx; cx.tid = threadIdx.x; cx.bid = blockIdx.x; cx.nblk = gridDim.x;
        asm volatile("" : "+v"(cx.tid)); asm volatile("" : "+s"(cx.bid)); asm volatile("" : "+s"(cx.nblk));
        uchar* ws = a.ws; asm volatile("" : "+s"(ws));
        float* H = a.out; asm volatile("" : "+s"(H));
        bf16_t* HB = (bf16_t*)(ws + WS_HB); float* ssq = (float*)(ws + WS_SSQ); float* ossq = (float*)(ws + WS_OSSQ);
        bf16_t* BIG = (bf16_t*)(ws + WS_BIG);
        bf16_t* Qb = BIG; bf16_t* Kb = BIG + (size_t)M_TOK * 1024; bf16_t* Vb = BIG + (size_t)M_TOK * 2048;
        StaticOrder S;
        if (ph == 0) { if constexpr (EN(100)) prep_phase(cx, lds, a); }
        else if (ph == NPHASE - 1) { if constexpr (EN(101)) final_phase(cx, a); }
        else {
            const int p = ph - 1, pair = p / 11, q = p % 11;
            const int L = 2 * pair + (q >= 5 ? 1 : 0);
            switch (q) {
            case 0: if constexpr (EN(0)) {
                Gemm g{HB, (const bf16_t*)(ws + WS_SGU_IN) + (size_t)pair * 2048 * 1024, M_TOK, 2048, 1024, 1024, 1024};
                S.init(M_TOK, 2048, cx.nblk, cx.bid, ph & 1); EpiGelu E{BIG, ssq}; gemm_phase<EpiGelu>(cx, lds, g, S, E); } break;
            case 1:
                if constexpr (EN(1)) sgu_mix_phase(cx, lds, BIG,
#if PROBE_Q == 1
                    (!probe_rep) ? (bf16_t*)(ws + WS_END) :
#endif
                    BIG, (const bf16_t*)(ws + WS_WSM) + (size_t)pair * 8 * 128 * 128, a.sgu_b_s + pair * 8 * 128, a.sgu_ln_g + pair * 1024, a.sgu_ln_b + pair * 1024);
                break;
            case 2: case 4: case 8: case 10: if constexpr (EN(2)) {
                Gemm g;
                if (q == 2) g = Gemm{BIG, (const bf16_t*)(ws + WS_SGU_OUT) + (size_t)pair * 1024 * 1024, M_TOK, 1024, 1024, 2048, 1024};
                else if (q == 8) g = Gemm{Vb, (const bf16_t*)(ws + WS_RET_OUT) + (size_t)pair * 1024 * 2048, M_TOK, 1024, 2048, 2048, 2048};
                else g = Gemm{BIG, (const bf16_t*)(ws + WS_DOWN) + (size_t)L * 1024 * FF, M_TOK, 1024, FF, FF, FF};
                S.init(M_TOK, 1024, cx.nblk, cx.bid, ph & 1); EpiRes E{HB, HB, ssq};
#if defined(PROBE_RES)
                if (!probe_rep && PROBE_MATCH(q)) E.HBout = (bf16_t*)(ws + WS_END);
#endif
                gemm_phase<EpiRes>(cx, lds, g, S, E); } break;
            case 3: case 9: if constexpr (EN(3)) {
                Gemm g{HB, (const bf16_t*)(ws + WS_GU) + (size_t)L * 5632 * 1024, M_TOK, 5632, 1024, 1024, 1024};
                S.init(M_TOK, 5632, cx.nblk, cx.bid, ph & 1); EpiSwiglu E{BIG, ssq}; gemm_phase<EpiSwiglu>(cx, lds, g, S, E); } break;
            case 5: if constexpr (EN(5)) {
                Gemm g{HB, (const bf16_t*)(ws + WS_RET_IN) + (size_t)pair * 6144 * 1024, M_TOK, 4096, 1024, 1024, 1024};
                S.init(M_TOK, 4096, cx.nblk, cx.bid, ph & 1); EpiQKV E{Qb, Kb, Vb, ssq, a.pos}; gemm_phase<EpiQKV>(cx, lds, g, S, E); } break;
            case 6:
                if constexpr (EN(6)) {
#if PROBE_Q == 6
                    if (!probe_rep) retention_phase(cx, lds, Qb, Kb, Vb, (bf16_t*)(ws + WS_END), ossq); else
#endif
                    retention_phase(cx, lds, Qb, Kb, Vb, Vb, ossq); }
                break;
            case 7: if constexpr (EN(7)) {
                Gemm g{HB, (const bf16_t*)(ws + WS_RET_IN) + (size_t)pair * 6144 * 1024 + (size_t)4096 * 1024, M_TOK, 2048, 1024, 1024, 1024};
                S.init(M_TOK, 2048, cx.nblk, cx.bid, ph & 1); EpiGate E{Vb, ssq, ossq, a.ret_gn_g + pair * 2048}; gemm_phase<EpiGate>(cx, lds, g, S, E); } break;
            default: break;
            }
        }
        if (ph + 1 < ph_hi) {
            if (ph < 0) { __threadfence(); cg::this_grid().sync(); }
            else xcd_barrier(bar);
        }
#if defined(PROBE_MATCH)
        {
            const int pq = (ph == 0) ? 100 : (ph == NPHASE - 1) ? 101 : ((ph - 1) % 11);
            if (PROBE_MATCH(pq) && !probe_rep) { probe_rep = 1; --ph; } else probe_rep = 0;
        }
#endif
    }
#endif
}

extern "C" void kernel_launch(void* const* d_in, const int* in_sizes, int n_in, void* d_out, int out_size, void* d_ws, size_t ws_size, hipStream_t stream) {
    static int grid = 0;
    if (grid == 0) {
        if (n_in != 16 || out_size != M_TOK * DM || ws_size < WS_END) { fprintf(stderr, "kernel_launch: unexpected shapes (n_in %d out %d ws %zu)\n", n_in, out_size, ws_size); grid = -1; return; }
        int dev = 0, cus = 0, per_cu = 0;
        hipGetDevice(&dev); hipDeviceGetAttribute(&cus, hipDeviceAttributeMultiprocessorCount, dev);
        if (hipFuncSetAttribute((const void*)mega_fwd, hipFuncAttributeMaxDynamicSharedMemorySize, LDS_BYTES) != hipSuccess) { fprintf(stderr, "kernel_launch: hipFuncSetAttribute failed\n"); grid = -1; return; }
        if (hipOccupancyMaxActiveBlocksPerMultiprocessor(&per_cu, (const void*)mega_fwd, 512, LDS_BYTES) != hipSuccess || per_cu < 1) per_cu = 1;
        (void)hipGetLastError();
        grid = cus * per_cu;
    }
    if (grid < 0) return;
    Args a{};
    a.x = (const float*)d_in[0]; a.pos = (const int*)d_in[1]; a.mix_g = (const float*)d_in[2]; a.ffn_g = (const float*)d_in[3]; a.fin_g = (const float*)d_in[4];
    a.sgu_w_in = (const float*)d_in[5]; a.sgu_w_s = (const float*)d_in[6]; a.sgu_b_s = (const float*)d_in[7]; a.sgu_ln_g = (const float*)d_in[8]; a.sgu_ln_b = (const float*)d_in[9];
    a.sgu_w_out = (const float*)d_in[10]; a.ret_w_in = (const float*)d_in[11]; a.ret_gn_g = (const float*)d_in[12]; a.ret_w_out = (const float*)d_in[13];
    a.ffn_w_gu = (const float*)d_in[14]; a.ffn_w_down = (const float*)d_in[15];
    a.out = (float*)d_out; a.ws = (uchar*)d_ws;
#if MODE_ONE_LAUNCH
    a.ph_lo = 0; a.ph_hi = NPHASE;
    if (hipMemsetAsync((uchar*)d_ws + WS_BAR, 0, 16384, stream) != hipSuccess) { fprintf(stderr, "kernel_launch: memset of the barrier words failed\n"); return; }
    void* args[] = {&a};
    hipError_t e = hipLaunchCooperativeKernel((const void*)mega_fwd, dim3(grid), dim3(512), args, LDS_BYTES, stream);
    if (e != hipSuccess) fprintf(stderr, "cooperative launch failed: %s (grid %d)\n", hipGetErrorString(e), grid);
#else
    for (int ph = 0; ph < NPHASE; ++ph) {
        a.ph_lo = ph; a.ph_hi = ph + 1;
        hipLaunchKernelGGL(mega_fwd, dim3(grid), dim3(512), LDS_BYTES, stream, a);
    }
#endif
}
```

```cpp
#include <hip/hip_runtime.h>
#include <hip/hip_cooperative_groups.h>
#include <cstdio>
namespace cg = cooperative_groups;

#ifndef MODE_ONE_LAUNCH
#define MODE_ONE_LAUNCH 1
#endif

#ifndef PROBE_Q
#define PROBE_Q -1
#endif
#ifndef PROBE_Q2
#define PROBE_Q2 -2
#endif
#if PROBE_Q >= 0
#define PROBE_MATCH(pq) ((pq) == PROBE_Q || (pq) == PROBE_Q2)
#endif
#ifndef TEST_PHASE
#define TEST_PHASE -1
#endif
#define EN(q) (TEST_PHASE < 0 || TEST_PHASE == (q))
#define LAS __attribute__((address_space(3)))
#define GAS __attribute__((address_space(1)))
typedef unsigned short bf16_t;
typedef unsigned char uchar;
typedef short bf16x8 __attribute__((ext_vector_type(8)));
typedef short s16x4 __attribute__((ext_vector_type(4)));
typedef float f32x4 __attribute__((ext_vector_type(4)));
typedef unsigned u32x4 __attribute__((ext_vector_type(4)));
typedef unsigned u32x2 __attribute__((ext_vector_type(2)));

constexpr int M_TOK = 65536, DM = 1024, SEQ = 8192, NCHUNK = 512, FF = 2816;
constexpr float EPS = 1e-6f;
constexpr int NPHASE = 24;

constexpr size_t MiB = 1024ull * 1024ull;
constexpr size_t WS_SGU_IN = 0;
constexpr size_t WS_SGU_OUT = 8 * MiB;
constexpr size_t WS_RET_IN = 12 * MiB;
constexpr size_t WS_RET_OUT = 36 * MiB;
constexpr size_t WS_GU = 44 * MiB;
constexpr size_t WS_DOWN = 88 * MiB;
constexpr size_t WS_WSM = 110 * MiB;
constexpr size_t WS_SSQ = 111 * MiB;
constexpr size_t WS_OSSQ = 115 * MiB;
constexpr size_t WS_HB = 124 * MiB;
constexpr size_t WS_BIG = 252 * MiB;
constexpr size_t WS_END = 764 * MiB;

constexpr int LDS_MAIN = 145408;
constexpr int LDS_BYTES = LDS_MAIN + 16;
constexpr size_t WS_BAR = 110 * MiB + 768 * 1024;

constexpr int BM = 256, BK = 64, HALF = 128, HTB = HALF * BK * 2, NXCD = 8, WGM = 8;

__device__ __forceinline__ int lds_byte(int r, int c) { const int st = (r >> 4) * 2 + (c >> 5), rr = r & 15, cc = c & 31, ob = rr * 64 + cc * 2; return st * 1024 + (ob ^ (((ob >> 9) & 1) << 5)); }
__device__ __forceinline__ void stage_rc(int b, int& R, int& C) { const int st = b / 1024, sb = b % 1024, swz = sb ^ (((sb >> 9) & 1) << 5); R = (st >> 1) * 16 + swz / 64; C = (st & 1) * 32 + (swz % 64) / 2; }
__device__ __forceinline__ int perm32(int rho) { const int n = rho >> 4, i = rho & 15; return 8 * (i >> 2) + 4 * n + (i & 3); }

template <class T> __device__ __forceinline__ T gld(const void* p) { return *(const GAS T*)p; }
template <class T> __device__ __forceinline__ void gst(void* p, const T v) { *(GAS T*)p = v; }
struct Ctx { int tid, bid, nblk; };
struct Unit { int pm, pn; };
struct Gemm { const bf16_t* A; const bf16_t* Bt; int M, N, K, lda, ldb; };

struct StaticOrder {
    int nM, nN, nwg, G, c, rev;
    __device__ void init(int M, int N, int G_, int c_, int rev_ = 0) { nM = M / BM; nN = N / BM; nwg = nM * nN; G = G_; c = c_; rev = rev_; }
    __device__ bool next(int i, Unit& u) const {
        const long L = (long)i * G + c; if (L >= nwg) return false;
        int wgid = (int)L; { const int q = nwg / NXCD, r = nwg % NXCD, xcd = wgid % NXCD; int off = wgid / NXCD; if (rev) off = q + (xcd < r ? 1 : 0) - 1 - off; wgid = (xcd < r ? xcd * (q + 1) : r * (q + 1) + (xcd - r) * q) + off; }
        const int nig = WGM * nN, gid = wgid / nig, fm = gid * WGM, gsz = (nM - fm) < WGM ? (nM - fm) : WGM;
        u.pm = fm + ((wgid % nig) % gsz); u.pn = (wgid % nig) / gsz; return true;
    }
};

__device__ __forceinline__ unsigned cvt_pk_bf16(float lo, float hi) { unsigned r; asm volatile("v_cvt_pk_bf16_f32 %0, %1, %2" : "=v"(r) : "v"(lo), "v"(hi)); return r; }
__device__ __forceinline__ float bf_lo(unsigned w) { return __uint_as_float(w << 16); }
__device__ __forceinline__ float bf_hi(unsigned w) { return __uint_as_float(w & 0xffff0000u); }
__device__ __forceinline__ float fast_sigmoid(float x) { return __builtin_amdgcn_rcpf(1.0f + __builtin_amdgcn_exp2f(-1.4426950408889634f * x)); }
__device__ __forceinline__ float silu_f(float x) { return x * fast_sigmoid(x); }
__device__ __forceinline__ float gelu_tanh(float x) { const float u = 0.7978845608028654f * (x + 0.044715f * x * x * x); return x * fast_sigmoid(2.0f * u); }

__device__ __forceinline__ float row_scale(const float* ssq, int r, int fq) {
    const f32x4 p = gld<f32x4>(ssq + (size_t)r * 16 + fq * 4);
    float s = (p[0] + p[1]) + (p[2] + p[3]);
    s += __shfl_xor(s, 16); s += __shfl_xor(s, 32);
    return __builtin_amdgcn_rsqf(s * (1.0f / 1024.0f) + EPS);
}
__device__ __forceinline__ void row_scales4(const float* ssq, int row0, int fq, float (&rs)[4]) {
    f32x4 p[4];
#pragma unroll
    for (int m = 0; m < 4; ++m) p[m] = gld<f32x4>(ssq + (size_t)(row0 + m * 16) * 16 + fq * 4);
    float s[4], t[4];
#pragma unroll
    for (int m = 0; m < 4; ++m) s[m] = (p[m][0] + p[m][1]) + (p[m][2] + p[m][3]);
#pragma unroll
    for (int m = 0; m < 4; ++m) t[m] = __shfl_xor(s[m], 16);
#pragma unroll
    for (int m = 0; m < 4; ++m) s[m] += t[m];
#pragma unroll
    for (int m = 0; m < 4; ++m) t[m] = __shfl_xor(s[m], 32);
#pragma unroll
    for (int m = 0; m < 4; ++m) rs[m] = __builtin_amdgcn_rsqf((s[m] + t[m]) * (1.0f / 1024.0f) + EPS);
}
__device__ __forceinline__ void row_scales8(const float* ssq, int row0, int fq, float (&rs)[2][4]) {
    row_scales4(ssq, row0, fq, rs[0]);
    row_scales4(ssq, row0 + HALF, fq, rs[1]);
}
struct EpiCtx { LAS uchar* lds; int wid, lane, pm_fresh; };
__device__ __forceinline__ void row_scales_cached(const EpiCtx& ec, const float* ssq, int pm, int wr, int fr, float (&rs)[2][4]) {
    LAS float* buf = (LAS float*)(ec.lds + 8 * HTB + ec.wid * 512);
    if (ec.pm_fresh) {
        f32x4 p[2][4];
#pragma unroll
        for (int h = 0; h < 2; ++h) {
            const int idx = ec.lane + 64 * h, row = pm * BM + (idx >> 6) * HALF + wr * 64 + (idx & 63);
#pragma unroll
            for (int k = 0; k < 4; ++k) p[h][k] = gld<f32x4>(ssq + (size_t)row * 16 + 4 * k);
        }
#pragma unroll
        for (int h = 0; h < 2; ++h) {
            const f32x4 t = (p[h][0] + p[h][1]) + (p[h][2] + p[h][3]);
            buf[ec.lane + 64 * h] = __builtin_amdgcn_rsqf(((t[0] + t[1]) + (t[2] + t[3])) * (1.0f / 1024.0f) + EPS);
        }
    }
#pragma unroll
    for (int ai = 0; ai < 2; ++ai)
#pragma unroll
        for (int m = 0; m < 4; ++m) rs[ai][m] = buf[ai * 64 + m * 16 + fr];
}

struct EpiGelu {
    static constexpr bool DUPK = false;
    bf16_t* Z; const float* ssq;
    __device__ __forceinline__ void operator()(const f32x4 (&acc)[2][2][4][2], const Unit& u, int wr, int wc, int fr, int fq, const EpiCtx& ec) const {
        const int row0 = u.pm * BM + wr * 64 + fr, col0 = u.pn * BM + wc * 32 + 8 * fq;
        float rsv[2][4];
        row_scales_cached(ec, ssq, u.pm, wr, fr, rsv);
#pragma unroll
        for (int ai = 0; ai < 2; ++ai)
#pragma unroll
            for (int m = 0; m < 4; ++m) {
                const int r = row0 + ai * HALF + m * 16; const float rs = rsv[ai][m];
                bf16_t* rowp = Z + (size_t)r * 2048 + col0;
#pragma unroll
                for (int bj = 0; bj < 2; ++bj) {
                    const f32x4 v0 = acc[ai][bj][m][0] * rs, v1 = acc[ai][bj][m][1] * rs;
                    u32x4 w; w.x = cvt_pk_bf16(gelu_tanh(v0[0]), gelu_tanh(v0[1])); w.y = cvt_pk_bf16(gelu_tanh(v0[2]), gelu_tanh(v0[3]));
                    w.z = cvt_pk_bf16(gelu_tanh(v1[0]), gelu_tanh(v1[1])); w.w = cvt_pk_bf16(gelu_tanh(v1[2]), gelu_tanh(v1[3]));
                    gst<u32x4>(rowp + bj * HALF, w); }
            }
    }
};

struct EpiRes {
    static constexpr bool DUPK = false;
    static constexpr bool ACC_INIT = false;
    bf16_t* HB; bf16_t* HBout; float* ssq;
    __device__ __forceinline__ void operator()(const f32x4 (&acc)[2][2][4][2], const Unit& u, int wr, int wc, int fr, int fq, const EpiCtx& ec) const {
        const int row0 = u.pm * BM + wr * 64 + fr, col0 = u.pn * BM + wc * 32 + 8 * fq;
        float qv[2][4];
        u32x4 hv[2][2][2];
#define RES_LOAD(buf, b) do { _Pragma("unroll") for (int mm = 0; mm < 2; ++mm) _Pragma("unroll") for (int bj = 0; bj < 2; ++bj) \
            hv[buf][mm][bj] = gld<u32x4>(HB + (size_t)(row0 + ((b) >> 1) * HALF + (2 * ((b) & 1) + mm) * 16) * DM + col0 + bj * HALF); } while (0)
        RES_LOAD(0, 0); RES_LOAD(1, 1);
#pragma unroll
        for (int b = 0; b < 4; ++b) {
            const int ai = b >> 1;
#pragma unroll
            for (int mm = 0; mm < 2; ++mm) {
                const int m = 2 * (b & 1) + mm, r = row0 + ai * HALF + m * 16; float q = 0.f;
#pragma unroll
                for (int bj = 0; bj < 2; ++bj) {
                    const u32x4 h = hv[b & 1][mm][bj];
                    const f32x4 a0 = acc[ai][bj][m][0], a1 = acc[ai][bj][m][1];
                    const float x0 = bf_lo(h.x) + a0[0], x1 = bf_hi(h.x) + a0[1], x2 = bf_lo(h.y) + a0[2], x3 = bf_hi(h.y) + a0[3];
                    const float x4 = bf_lo(h.z) + a1[0], x5 = bf_hi(h.z) + a1[1], x6 = bf_lo(h.w) + a1[2], x7 = bf_hi(h.w) + a1[3];
                    u32x4 w; w.x = cvt_pk_bf16(x0, x1); w.y = cvt_pk_bf16(x2, x3); w.z = cvt_pk_bf16(x4, x5); w.w = cvt_pk_bf16(x6, x7);
                    gst<u32x4>(HBout + (size_t)r * DM + col0 + bj * HALF, w);
                    q += ((x0 * x0 + x1 * x1) + (x2 * x2 + x3 * x3)) + ((x4 * x4 + x5 * x5) + (x6 * x6 + x7 * x7));
                }
                qv[ai][m] = q;
            }
            if (b < 2) RES_LOAD(b & 1, b + 2);
        }
#undef RES_LOAD
        float tv[2][4];
#pragma unroll
        for (int ai = 0; ai < 2; ++ai)
#pragma unroll
            for (int m = 0; m < 4; ++m) tv[ai][m] = __shfl_xor(qv[ai][m], 16);
#pragma unroll
        for (int ai = 0; ai < 2; ++ai)
#pragma unroll
            for (int m = 0; m < 4; ++m) qv[ai][m] += tv[ai][m];
#pragma unroll
        for (int ai = 0; ai < 2; ++ai)
#pragma unroll
            for (int m = 0; m < 4; ++m) tv[ai][m] = __shfl_xor(qv[ai][m], 32);
        if (fq == 0) {
#pragma unroll
            for (int ai = 0; ai < 2; ++ai)
#pragma unroll
                for (int m = 0; m < 4; ++m) gst<float>(ssq + (size_t)(row0 + ai * HALF + m * 16) * 16 + u.pn * 4 + wc, qv[ai][m] + tv[ai][m]);
        }
    }
};

struct EpiSwiglu {
#ifdef PROBE_DUPK
    static constexpr bool DUPK = true;
#else
    static constexpr bool DUPK = false;
#endif
    bf16_t* ACT; const float* ssq;
    __device__ __forceinline__ void operator()(const f32x4 (&acc)[2][2][4][2], const Unit& u, int wr, int wc, int fr, int fq, const EpiCtx& ec) const {
        const int row0 = u.pm * BM + wr * 64 + fr, col0 = u.pn * HALF + wc * 32 + 8 * fq;
        float rsv[2][4];
        row_scales_cached(ec, ssq, u.pm, wr, fr, rsv);
#pragma unroll
        for (int ai = 0; ai < 2; ++ai)
#pragma unroll
            for (int m = 0; m < 4; ++m) {
                const int r = row0 + ai * HALF + m * 16; const float rs = rsv[ai][m];
                const float rs2 = DUPK ? rs * 0.5f : rs;
                const f32x4 a0 = acc[ai][0][m][0] * rs2, a1 = acc[ai][0][m][1] * rs2, b0 = acc[ai][1][m][0] * rs2, b1 = acc[ai][1][m][1] * rs2;
                u32x4 w; w.x = cvt_pk_bf16(silu_f(a0[0]) * b0[0], silu_f(a0[1]) * b0[1]); w.y = cvt_pk_bf16(silu_f(a0[2]) * b0[2], silu_f(a0[3]) * b0[3]);
                w.z = cvt_pk_bf16(silu_f(a1[0]) * b1[0], silu_f(a1[1]) * b1[1]); w.w = cvt_pk_bf16(silu_f(a1[2]) * b1[2], silu_f(a1[3]) * b1[3]);
                gst<u32x4>(ACT + (size_t)r * FF + col0, w);
            }
    }
};

struct EpiQKV {
    static constexpr bool DUPK = false;
    bf16_t* Q; bf16_t* Kb; bf16_t* V; const float* ssq; const int* pos;
    __device__ __forceinline__ void operator()(const f32x4 (&acc)[2][2][4][2], const Unit& u, int wr, int wc, int fr, int fq, const EpiCtx& ec) const {
        const int row0 = u.pm * BM + wr * 64 + fr, i0 = wc * 32 + 8 * fq;
        float rsa[2][4]; row_scales_cached(ec, ssq, u.pm, wr, fr, rsa);
        if (u.pn >= 8) {
            const int col0 = (u.pn - 8) * BM + i0;
#pragma unroll
            for (int ai = 0; ai < 2; ++ai) {
                float rsv[4];
#pragma unroll
                for (int m = 0; m < 4; ++m) rsv[m] = rsa[ai][m];
#pragma unroll
                for (int m = 0; m < 4; ++m) {
                    const int r = row0 + ai * HALF + m * 16; const float rs = rsv[m];
#pragma unroll
                    for (int bj = 0; bj < 2; ++bj) {
                        const f32x4 v0 = acc[ai][bj][m][0] * rs, v1 = acc[ai][bj][m][1] * rs;
                        u32x4 w; w.x = cvt_pk_bf16(v0[0], v0[1]); w.y = cvt_pk_bf16(v0[2], v0[3]); w.z = cvt_pk_bf16(v1[0], v1[1]); w.w = cvt_pk_bf16(v1[2], v1[3]);
                        gst<u32x4>(V + (size_t)r * 2048 + col0 + bj * HALF, w); }
                }
            }
        } else {
            bf16_t* dst = (u.pn < 4 ? Q : Kb) + (u.pn & 3) * BM + i0; const float sc = u.pn < 4 ? 1.0f : 0.0625f;
#pragma unroll
            for (int ai = 0; ai < 2; ++ai) {
                float rsv[4], pv[4];
#pragma unroll
                for (int m = 0; m < 4; ++m) pv[m] = (float)gld<int>(pos + row0 + ai * HALF + m * 16);
#pragma unroll
                for (int m = 0; m < 4; ++m) rsv[m] = rsa[ai][m];
#pragma unroll
                for (int m = 0; m < 4; ++m) {
                    const int r = row0 + ai * HALF + m * 16; const float rs = rsv[m] * sc; const float p = pv[m];
#pragma unroll
                    for (int n = 0; n < 2; ++n) {
                        float o1[4], o2[4];
#pragma unroll
                        for (int e = 0; e < 4; ++e) {
                            const float inv = __builtin_amdgcn_exp2f(-(float)(i0 + 4 * n + e) * (13.287712379549449f / 128.0f)) * 0.15915494309189535f;
                            float t = p * inv; t = t - floorf(t);
                            const float sn = __builtin_amdgcn_sinf(t), cs = __builtin_amdgcn_cosf(t);
                            const float x1 = acc[ai][0][m][n][e] * rs, x2 = acc[ai][1][m][n][e] * rs;
                            o1[e] = x1 * cs - x2 * sn; o2[e] = x1 * sn + x2 * cs; }
                        u32x2 w1, w2; w1.x = cvt_pk_bf16(o1[0], o1[1]); w1.y = cvt_pk_bf16(o1[2], o1[3]); w2.x = cvt_pk_bf16(o2[0], o2[1]); w2.y = cvt_pk_bf16(o2[2], o2[3]);
                        gst<u32x2>(dst + (size_t)r * DM + 4 * n, w1); gst<u32x2>(dst + (size_t)r * DM + HALF + 4 * n, w2);
                    }
                }
            }
        }
    }
};

__device__ __forceinline__ void head_scales4(const float* ossq, int row0, int head, int fq, float (&ri)[4]) {
    float q0[4], q1[4], s[4], t[4];
#pragma unroll
    for (int m = 0; m < 4; ++m) { const float* p = ossq + (size_t)(row0 + m * 16) * 32 + head * 8 + fq * 2; q0[m] = gld<float>(p); q1[m] = gld<float>(p + 1); }
#pragma unroll
    for (int m = 0; m < 4; ++m) s[m] = q0[m] + q1[m];
#pragma unroll
    for (int m = 0; m < 4; ++m) t[m] = __shfl_xor(s[m], 16);
#pragma unroll
    for (int m = 0; m < 4; ++m) s[m] += t[m];
#pragma unroll
    for (int m = 0; m < 4; ++m) t[m] = __shfl_xor(s[m], 32);
#pragma unroll
    for (int m = 0; m < 4; ++m) ri[m] = __builtin_amdgcn_rsqf((s[m] + t[m]) * (1.0f / 512.0f) + EPS);
}
struct EpiGate {
    static constexpr bool ACC_INIT = false;
    static constexpr bool DUPK = false;
    bf16_t* O; const float* ssq; const float* ossq; const float* gn;
    __device__ __forceinline__ void operator()(const f32x4 (&acc)[2][2][4][2], const Unit& u, int wr, int wc, int fr, int fq, const EpiCtx& ec) const {
        const int row0 = u.pm * BM + wr * 64 + fr, col0 = u.pn * BM + wc * 32 + 8 * fq, head = u.pn >> 1;
        float rsv[2][4], rinv[2][4];
        row_scales_cached(ec, ssq, u.pm, wr, fr, rsv);
        float q0[2][4], q1[2][4];
#pragma unroll
        for (int ai = 0; ai < 2; ++ai)
#pragma unroll
            for (int m = 0; m < 4; ++m) { const float* p = ossq + (size_t)(row0 + ai * HALF + m * 16) * 32 + head * 8 + fq * 2; q0[ai][m] = gld<float>(p); q1[ai][m] = gld<float>(p + 1); }
        f32x4 gg[2][2];
#pragma unroll
        for (int bj = 0; bj < 2; ++bj) { gg[bj][0] = gld<f32x4>(gn + col0 + bj * HALF); gg[bj][1] = gld<f32x4>(gn + col0 + bj * HALF + 4); }
        u32x4 ov[2][2][2];
#define GATE_LOAD(buf, b) do { _Pragma("unroll") for (int mm = 0; mm < 2; ++mm) _Pragma("unroll") for (int bj = 0; bj < 2; ++bj) \
            ov[buf][mm][bj] = gld<u32x4>(O + (size_t)(row0 + ((b) >> 1) * HALF + (2 * ((b) & 1) + mm) * 16) * 2048 + col0 + bj * HALF); } while (0)
        GATE_LOAD(0, 0);
        {
            float s[2][4], t[2][4];
#pragma unroll
            for (int ai = 0; ai < 2; ++ai)
#pragma unroll
                for (int m = 0; m < 4; ++m) s[ai][m] = q0[ai][m] + q1[ai][m];
#pragma unroll
            for (int ai = 0; ai < 2; ++ai)
#pragma unroll
                for (int m = 0; m < 4; ++m) t[ai][m] = __shfl_xor(s[ai][m], 16);
#pragma unroll
            for (int ai = 0; ai < 2; ++ai)
#pragma unroll
                for (int m = 0; m < 4; ++m) s[ai][m] += t[ai][m];
#pragma unroll
            for (int ai = 0; ai < 2; ++ai)
#pragma unroll
                for (int m = 0; m < 4; ++m) t[ai][m] = __shfl_xor(s[ai][m], 32);
#pragma unroll
            for (int ai = 0; ai < 2; ++ai)
#pragma unroll
                for (int m = 0; m < 4; ++m) rinv[ai][m] = __builtin_amdgcn_rsqf((s[ai][m] + t[ai][m]) * (1.0f / 512.0f) + EPS);
        }
        GATE_LOAD(1, 1);
#pragma unroll
        for (int b = 0; b < 4; ++b) {
            const int ai = b >> 1;
#pragma unroll
            for (int mm = 0; mm < 2; ++mm) {
                const int m = 2 * (b & 1) + mm, r = row0 + ai * HALF + m * 16; const float rs = rsv[ai][m], ri = rinv[ai][m];
#pragma unroll
                for (int bj = 0; bj < 2; ++bj) {
                    const u32x4 o = ov[b & 1][mm][bj];
                    const f32x4 g0 = gg[bj][0] * ri, g1 = gg[bj][1] * ri;
                    const f32x4 a0 = acc[ai][bj][m][0] * rs, a1 = acc[ai][bj][m][1] * rs;
                    u32x4 w;
                    w.x = cvt_pk_bf16(bf_lo(o.x) * g0[0] * silu_f(a0[0]), bf_hi(o.x) * g0[1] * silu_f(a0[1]));
                    w.y = cvt_pk_bf16(bf_lo(o.y) * g0[2] * silu_f(a0[2]), bf_hi(o.y) * g0[3] * silu_f(a0[3]));
                    w.z = cvt_pk_bf16(bf_lo(o.z) * g1[0] * silu_f(a1[0]), bf_hi(o.z) * g1[1] * silu_f(a1[1]));
                    w.w = cvt_pk_bf16(bf_lo(o.w) * g1[2] * silu_f(a1[2]), bf_hi(o.w) * g1[3] * silu_f(a1[3]));
                    gst<u32x4>(O + (size_t)r * 2048 + col0 + bj * HALF, w); }
            }
            if (b < 2) GATE_LOAD(b & 1, b + 2);
        }
#undef GATE_LOAD
    }
};

template <class Epi>
__device__ __forceinline__ void gemm_phase(const Ctx cx, LAS uchar* lds, const Gemm g, const StaticOrder& S, const Epi& E) {
    const int tid = cx.tid, wid = __builtin_amdgcn_readfirstlane(tid >> 6), lane = tid & 63, wr = wid >> 2, wc = wid & 3, fr = lane & 15, fq = lane >> 4;
    const int K = g.K, nt = K / BK;
    unsigned voffA[2], voffB[2];
#pragma unroll
    for (int i = 0; i < 2; ++i) { int R, C; stage_rc(tid * 16 + i * 8192, R, C); const int Rb = (R & ~31) + perm32(R & 31);
        voffA[i] = (unsigned)(R * g.lda + C) * 2u; voffB[i] = (unsigned)(Rb * g.ldb + C) * 2u; }
    const size_t kstep = (size_t)(BK * 2);
    const size_t hstepA = (size_t)HALF * g.lda * 2, hstepB = (size_t)HALF * g.ldb * 2;
    const size_t tstepA = 2 * hstepA, tstepB = 2 * hstepB;
    const unsigned ldsw = (unsigned)wid * 1024u;
    const int aoff = lds_byte(wr * 64 + fr, fq * 8), boff = lds_byte(wc * 32 + fr, fq * 8);
#define PG8_SA(b, h) (((b) * 2 + (h)) * HTB)
#define PG8_SB(b, h) ((4 + (b) * 2 + (h)) * HTB)
#define PG8_STAGE(bufoff, gbase, voff) do { const char* _gb = (const char*)(gbase); asm volatile("" : "+s"(_gb));   \
    _Pragma("unroll") for (int _i = 0; _i < 2; ++_i) { asm volatile("" : "+v"((voff)[_i]));   \
        __builtin_amdgcn_global_load_lds((const unsigned*)(_gb + (voff)[_i]), (LAS unsigned*)(lds + (bufoff) + ldsw + _i * 8192), 16, 0, 0); } } while (0)
#define PG8_LDA(dst, b, h) do { _Pragma("unroll") for (int m = 0; m < 4; ++m) _Pragma("unroll") for (int k = 0; k < 2; ++k) dst[m][k] = *(const LAS bf16x8*)(lds + PG8_SA(b, h) + aoff + m * 2048 + k * 1024); } while (0)
#define PG8_LDB(dst, b, h) do { _Pragma("unroll") for (int n = 0; n < 2; ++n) _Pragma("unroll") for (int k = 0; k < 2; ++k) dst[n][k] = *(const LAS bf16x8*)(lds + PG8_SB(b, h) + boff + n * 2048 + k * 1024); } while (0)
#define PG8_MMA(ai, bj, At, Bt) do { __builtin_amdgcn_s_setprio(3); _Pragma("unroll") for (int m = 0; m < 4; ++m) _Pragma("unroll") for (int n = 0; n < 2; ++n) _Pragma("unroll") for (int k = 0; k < 2; ++k) \
        acc[ai][bj][m][n] = __builtin_amdgcn_mfma_f32_16x16x32_bf16(Bt[n][k], At[m][k], acc[ai][bj][m][n], 0, 0, 0); __builtin_amdgcn_s_setprio(0); } while (0)
#define PG8_WAIT_V(n) asm volatile("s_waitcnt vmcnt(" #n ")" ::: "memory")
#define PG8_WAIT_L(n) asm volatile("s_waitcnt lgkmcnt(" #n ")" ::: "memory")
#define PG8_BAR __builtin_amdgcn_s_barrier()
#define PG8_SCHED __builtin_amdgcn_sched_barrier(0)
    Unit cur, nxt; int ui = 0; int prev_pm = -1;
    if (!S.next(0, cur)) return;
    f32x4 acc[2][2][4][2];
#pragma unroll
    for (int a = 0; a < 2; ++a)
#pragma unroll
        for (int b = 0; b < 2; ++b)
#pragma unroll
            for (int m = 0; m < 4; ++m)
#pragma unroll
                for (int n = 0; n < 2; ++n) acc[a][b][m][n] = (f32x4){0.f, 0.f, 0.f, 0.f};
    bf16x8 At[4][2], B0[2][2], B1[2][2];
    const char* cA = (const char*)g.A + (size_t)cur.pm * tstepA; const char* cB = (const char*)g.Bt + (size_t)cur.pn * tstepB;
    PG8_STAGE(PG8_SB(0, 0), cB, voffB); PG8_STAGE(PG8_SA(0, 0), cA, voffA); PG8_STAGE(PG8_SB(0, 1), cB + hstepB, voffB); PG8_STAGE(PG8_SA(0, 1), cA + hstepA, voffA);
    if (wr == 1) PG8_BAR;
    PG8_WAIT_V(4); PG8_BAR;
    PG8_STAGE(PG8_SB(1, 0), cB + kstep, voffB); PG8_STAGE(PG8_SA(1, 0), cA + kstep, voffA); PG8_STAGE(PG8_SB(1, 1), cB + hstepB + kstep, voffB);
    PG8_WAIT_V(6); PG8_BAR;
    for (;;) {
        const bool has_next = S.next(ui + 1, nxt);
        const char* nA = has_next ? (const char*)g.A + (size_t)nxt.pm * tstepA : cA; const char* nB = has_next ? (const char*)g.Bt + (size_t)nxt.pn * tstepB : cB;
        for (int tt = 0; tt < (Epi::DUPK ? 2 : 1) * nt; tt += 2) {
            const int t = tt < nt ? tt : tt - nt;
            const bool last = (tt == (Epi::DUPK ? 2 : 1) * nt - 2);
            const int t2 = (t + 2 == nt) ? 0 : t + 2;
            const char* a1 = cA + (size_t)(t + 1) * kstep;
            const char* a2 = last ? nA : cA + (size_t)t2 * kstep; const char* b2 = last ? nB : cB + (size_t)t2 * kstep;
            const char* a3 = a2 + kstep; const char* b3 = b2 + kstep;
            PG8_LDB(B0, 0, 0); PG8_SCHED; PG8_LDA(At, 0, 0); PG8_STAGE(PG8_SA(1, 1), a1 + hstepA, voffA);
            PG8_WAIT_L(8); PG8_BAR; PG8_WAIT_L(0); PG8_MMA(0, 0, At, B0); PG8_BAR; PG8_SCHED;
            PG8_LDB(B1, 0, 1); PG8_STAGE(PG8_SB(0, 0), b2, voffB);
            PG8_BAR; PG8_WAIT_L(0); PG8_MMA(0, 1, At, B1); PG8_BAR;
            PG8_LDA(At, 0, 1); PG8_STAGE(PG8_SA(0, 0), a2, voffA);
            PG8_BAR; PG8_WAIT_L(0); PG8_MMA(1, 0, At, B0); PG8_BAR; PG8_SCHED;
            PG8_STAGE(PG8_SB(0, 1), b2 + hstepB, voffB);
            PG8_WAIT_V(6); PG8_BAR; PG8_MMA(1, 1, At, B1); PG8_BAR;
            PG8_LDB(B0, 1, 0); PG8_SCHED; PG8_LDA(At, 1, 0); PG8_STAGE(PG8_SA(0, 1), a2 + hstepA, voffA);
            PG8_WAIT_L(8); PG8_BAR; PG8_WAIT_L(0); PG8_MMA(0, 0, At, B0); PG8_BAR; PG8_SCHED;
            PG8_LDB(B1, 1, 1); PG8_STAGE(PG8_SB(1, 0), b3, voffB);
            PG8_BAR; PG8_WAIT_L(0); PG8_MMA(0, 1, At, B1); PG8_BAR;
            PG8_LDA(At, 1, 1); PG8_STAGE(PG8_SA(1, 0), a3, voffA);
            PG8_BAR; PG8_WAIT_L(0); PG8_MMA(1, 0, At, B0); PG8_BAR; PG8_SCHED;
            PG8_STAGE(PG8_SB(1, 1), b3 + hstepB, voffB);
            PG8_WAIT_V(6); PG8_BAR; PG8_MMA(1, 1, At, B1); PG8_BAR;
        }
        {
            int fr_e = fr, fq_e = fq; asm volatile("" : "+v"(fr_e), "+v"(fq_e));
            EpiCtx ec; ec.lds = lds; ec.wid = wid; ec.lane = fr_e + 16 * fq_e; ec.pm_fresh = (cur.pm != prev_pm); prev_pm = cur.pm;
            E(acc, cur, wr, wc, fr_e, fq_e, ec);
        }
        if (!has_next) break;
#pragma unroll
        for (int a = 0; a < 2; ++a)
#pragma unroll
            for (int b = 0; b < 2; ++b)
#pragma unroll
                for (int m = 0; m < 4; ++m)
#pragma unroll
                    for (int n = 0; n < 2; ++n) acc[a][b][m][n] = (f32x4){0.f, 0.f, 0.f, 0.f};
        cur = nxt; cA = nA; cB = nB; ++ui;
    }
    PG8_WAIT_V(0);
    if (wr == 0) PG8_BAR;
    PG8_BAR;
#undef PG8_SA
#undef PG8_SB
#undef PG8_STAGE
#undef PG8_LDA
#undef PG8_LDB
#undef PG8_MMA
#undef PG8_WAIT_V
#undef PG8_WAIT_L
#undef PG8_BAR
#undef PG8_SCHED
}

struct Args {
    const float* x; const int* pos; const float* mix_g; const float* ffn_g; const float* fin_g;
    const float* sgu_w_in; const float* sgu_w_s; const float* sgu_b_s; const float* sgu_ln_g; const float* sgu_ln_b; const float* sgu_w_out;
    const float* ret_w_in; const float* ret_gn_g; const float* ret_w_out; const float* ffn_w_gu; const float* ffn_w_down;
    float* out; uchar* ws; int ph_lo, ph_hi;
};

struct TileJob { const float* W; bf16_t* Wt; const float* gain; int K, N, tk, src0, n0; };
__device__ __forceinline__ TileJob decode_tile(const Args& a, uchar* ws, int tile) {
    TileJob t; int r, mode = 0, ntk;
    if (tile < 5632) {
        const int j = tile / 2816; r = tile - j * 2816;
        if (r < 512)       { t.W = a.sgu_w_in + (size_t)j * 1024 * 2048; t.Wt = (bf16_t*)(ws + WS_SGU_IN) + (size_t)j * 2048 * 1024; t.gain = a.mix_g + (2 * j) * 1024; t.K = 1024; t.N = 2048; }
        else if (r < 768)  { r -= 512;  t.W = a.sgu_w_out + (size_t)j * 1024 * 1024; t.Wt = (bf16_t*)(ws + WS_SGU_OUT) + (size_t)j * 1024 * 1024; t.gain = nullptr; t.K = 1024; t.N = 1024; }
        else if (r < 2304) { r -= 768;  t.W = a.ret_w_in + (size_t)j * 1024 * 6144; t.Wt = (bf16_t*)(ws + WS_RET_IN) + (size_t)j * 6144 * 1024; t.gain = a.mix_g + (2 * j + 1) * 1024; t.K = 1024; t.N = 6144; }
        else               { r -= 2304; t.W = a.ret_w_out + (size_t)j * 2048 * 1024; t.Wt = (bf16_t*)(ws + WS_RET_OUT) + (size_t)j * 1024 * 2048; t.gain = nullptr; t.K = 2048; t.N = 1024; }
    } else {
        const int t2 = tile - 5632, i = t2 / 2112; r = t2 - i * 2112;
        if (r < 1408) { t.W = a.ffn_w_gu + (size_t)i * 1024 * 5632; t.Wt = (bf16_t*)(ws + WS_GU) + (size_t)i * 5632 * 1024; t.gain = a.ffn_g + i * 1024; t.K = 1024; t.N = 5632; mode = 1; }
        else          { r -= 1408; t.W = a.ffn_w_down + (size_t)i * FF * 1024; t.Wt = (bf16_t*)(ws + WS_DOWN) + (size_t)i * 1024 * FF; t.gain = nullptr; t.K = FF; t.N = 1024; }
    }
    ntk = t.K / 64; t.tk = r % ntk; t.n0 = (r / ntk) * 64; t.src0 = t.n0;
    if (mode == 1) { const int tt = t.n0 >> 8, half = (t.n0 >> 7) & 1, jj = t.n0 & 127; t.src0 = half * FF + tt * 128 + jj; }
    return t;
}
constexpr int N_WTILES = 5632 + 8448;

__device__ __forceinline__ void x_row_finish(const f32x4 (&v)[4], int r, int lane, bf16_t* HB, float* ssq) {
    float q = 0.f;
#pragma unroll
    for (int i = 0; i < 4; ++i) {
        const int c = i * 256 + lane * 4;
        u32x2 w; w.x = cvt_pk_bf16(v[i][0], v[i][1]); w.y = cvt_pk_bf16(v[i][2], v[i][3]);
        gst<u32x2>(HB + (size_t)r * DM + c, w);
        q += (bf_lo(w.x) * bf_lo(w.x) + bf_hi(w.x) * bf_hi(w.x)) + (bf_lo(w.y) * bf_lo(w.y) + bf_hi(w.y) * bf_hi(w.y));
    }
#pragma unroll
    for (int o = 32; o >= 1; o >>= 1) q += __shfl_xor(q, o);
    if (lane < 16) gst<float>(ssq + (size_t)r * 16 + lane, (lane == 0) ? q : 0.f);
}

__device__ __forceinline__ void prep_phase(const Ctx cx, LAS uchar* lds, const Args& a) {
    LAS float* tile = (LAS float*)lds;
    uchar* ws = a.ws;
    bf16_t* HB = (bf16_t*)(ws + WS_HB); float* ssq = (float*)(ws + WS_SSQ);
    const int lane = cx.tid & 63, gw = cx.bid * 8 + (cx.tid >> 6), nw = cx.nblk * 8;
    int xr = gw;
    {
        const int tid = cx.tid, kl = tid >> 4, nl4 = (tid & 15) * 4, nl = tid >> 3, kc = (tid & 7) * 8;
        f32x4 v[2]; float gsc[2]; f32x4 xv[4];
        int cur = cx.bid;
        TileJob tj = decode_tile(a, ws, cur < N_WTILES ? cur : 0);
#pragma unroll
        for (int pass = 0; pass < 2; ++pass) { const int k = tj.tk * 64 + pass * 32 + kl; v[pass] = gld<f32x4>(tj.W + (size_t)k * tj.N + tj.src0 + nl4); gsc[pass] = tj.gain ? gld<float>(tj.gain + k) : 1.0f; }
        if (xr < M_TOK) {
#pragma unroll
            for (int i = 0; i < 4; ++i) xv[i] = gld<f32x4>(a.x + (size_t)xr * DM + i * 256 + lane * 4);
        }
        for (; cur < N_WTILES; cur += cx.nblk) {
#pragma unroll
            for (int pass = 0; pass < 2; ++pass) {
                LAS float* tp = tile + (pass * 32 + kl) * 65 + nl4;
                tp[0] = v[pass][0] * gsc[pass]; tp[1] = v[pass][1] * gsc[pass]; tp[2] = v[pass][2] * gsc[pass]; tp[3] = v[pass][3] * gsc[pass];
            }
            __syncthreads();
            const TileJob tc = tj;
            const int nxt = cur + cx.nblk;
            if (nxt < N_WTILES) {
                tj = decode_tile(a, ws, nxt);
#pragma unroll
                for (int pass = 0; pass < 2; ++pass) { const int k = tj.tk * 64 + pass * 32 + kl; v[pass] = gld<f32x4>(tj.W + (size_t)k * tj.N + tj.src0 + nl4); gsc[pass] = tj.gain ? gld<float>(tj.gain + k) : 1.0f; }
            }
            float e[8];
#pragma unroll
            for (int i = 0; i < 8; ++i) e[i] = tile[(kc + i) * 65 + nl];
            u32x4 w; w.x = cvt_pk_bf16(e[0], e[1]); w.y = cvt_pk_bf16(e[2], e[3]); w.z = cvt_pk_bf16(e[4], e[5]); w.w = cvt_pk_bf16(e[6], e[7]);
            gst<u32x4>(tc.Wt + (size_t)(tc.n0 + nl) * tc.K + tc.tk * 64 + kc, w);
            if (xr < M_TOK) {
                x_row_finish(xv, xr, lane, HB, ssq);
                xr += nw;
                if (xr < M_TOK) {
#pragma unroll
                    for (int i = 0; i < 4; ++i) xv[i] = gld<f32x4>(a.x + (size_t)xr * DM + i * 256 + lane * 4);
                }
            }
            __syncthreads();
        }
        while (xr < M_TOK) {
            x_row_finish(xv, xr, lane, HB, ssq);
            xr += nw;
            if (xr < M_TOK) {
#pragma unroll
                for (int i = 0; i < 4; ++i) xv[i] = gld<f32x4>(a.x + (size_t)xr * DM + i * 256 + lane * 4);
            }
        }
    }
    {
        bf16_t* wm = (bf16_t*)(ws + WS_WSM);
        const int total = 2 * 8 * 128 * 128;
        for (int i = (cx.bid * 512 + cx.tid) * 2; i < total; i += cx.nblk * 512 * 2) {
            const int s = i & 127, t = (i >> 7) & 127;
            const float v0 = (s <= t) ? gld<float>(a.sgu_w_s + i) : 0.f, v1 = (s + 1 <= t) ? gld<float>(a.sgu_w_s + i + 1) : 0.f;
            gst<unsigned>(wm + i, cvt_pk_bf16(v0, v1));
        }
    }
}

__device__ __forceinline__ void final_phase(const Ctx cx, const Args& a) {
    const int lane = cx.tid & 63, gw = cx.bid * 8 + (cx.tid >> 6), nw = cx.nblk * 8;
    float* H = a.out; const bf16_t* HB = (const bf16_t*)(a.ws + WS_HB); const float* ssq = (const float*)(a.ws + WS_SSQ);
    for (int r = gw; r < M_TOK; r += nw) {
        float s = gld<float>(ssq + (size_t)r * 16 + (lane & 15));
        s += __shfl_xor(s, 1); s += __shfl_xor(s, 2); s += __shfl_xor(s, 4); s += __shfl_xor(s, 8);
        const float rs = rsqrtf(s * (1.0f / 1024.0f) + EPS);
#pragma unroll
        for (int i = 0; i < 4; ++i) {
            const int c = i * 256 + lane * 4;
            const u32x2 hv = gld<u32x2>(HB + (size_t)r * DM + c); const f32x4 g = gld<f32x4>(a.fin_g + c);
            const f32x4 v = (f32x4){bf_lo(hv.x), bf_hi(hv.x), bf_lo(hv.y), bf_hi(hv.y)};
            gst<f32x4>(H + (size_t)r * DM + c, v * rs * g);
        }
    }
}

__device__ __forceinline__ s16x4 tr_read(LAS uchar* p) { return __builtin_amdgcn_ds_read_tr16_b64_v4i16((LAS s16x4*)p); }
__device__ __forceinline__ bf16x8 cat8(s16x4 a, s16x4 b) { return __builtin_shufflevector(a, b, 0, 1, 2, 3, 4, 5, 6, 7); }

__device__ __forceinline__ void sgu_mix_phase(const Ctx cx, LAS uchar* lds, bf16_t* Z, bf16_t* Zout, const bf16_t* Wm, const float* bs, const float* lng, const float* lnb) {
    constexpr int VST = 288;
    LAS float* stats = (LAS float*)lds;
    LAS uchar* vimg = lds + 1024;
    LAS float* lgb = (LAS float*)(lds + 1024 + 128 * VST);
    const int tid = cx.tid, wid = __builtin_amdgcn_readfirstlane(tid >> 6), lane = tid & 63, fr = lane & 15, fq = lane >> 4;
    const int q4 = fr >> 2, p4 = fr & 3;
    __syncthreads();
    for (int i = tid; i < 2048; i += 512) lgb[i] = gld<float>((i < 1024 ? lng : lnb - 1024) + i);
    const int nit = (cx.nblk == 256) ? 2 : (NCHUNK + cx.nblk - 1) / cx.nblk;
    for (int it = 0; it < nit; ++it) {
        const int chunk = (cx.nblk == 256) ? ((cx.bid & 7) * 64 + (cx.bid >> 3) + 32 * it) : (cx.bid + it * cx.nblk);
        if (chunk >= NCHUNK) break;
        bf16_t* zc = Z + (size_t)chunk * 128 * 2048;
        __syncthreads();
#pragma unroll 1
        for (int i4 = 0; i4 < 4; ++i4) {
            u32x4 ra[4], rb[4];
#pragma unroll
            for (int i = 0; i < 4; ++i) { const bf16_t* p = zc + (size_t)(wid * 16 + i4 * 4 + i) * 2048 + 1024 + lane * 16; ra[i] = gld<u32x4>(p); rb[i] = gld<u32x4>(p + 8); }
            float s[4], q[4];
#pragma unroll
            for (int i = 0; i < 4; ++i) {
                s[i] = 0.f; q[i] = 0.f;
#pragma unroll
                for (int e = 0; e < 4; ++e) { const float x0 = bf_lo(ra[i][e]), x1 = bf_hi(ra[i][e]), x2 = bf_lo(rb[i][e]), x3 = bf_hi(rb[i][e]); s[i] += (x0 + x1) + (x2 + x3); q[i] += (x0 * x0 + x1 * x1) + (x2 * x2 + x3 * x3); }
            }
#pragma unroll
            for (int o = 32; o >= 1; o >>= 1) {
                float ts[4], tq[4];
#pragma unroll
                for (int i = 0; i < 4; ++i) { ts[i] = __shfl_xor(s[i], o); tq[i] = __shfl_xor(q[i], o); }
#pragma unroll
                for (int i = 0; i < 4; ++i) { s[i] += ts[i]; q[i] += tq[i]; }
            }
            if (lane < 4) {
                const float sv = lane == 0 ? s[0] : lane == 1 ? s[1] : lane == 2 ? s[2] : s[3], qv = lane == 0 ? q[0] : lane == 1 ? q[1] : lane == 2 ? q[2] : q[3];
                const float mean = sv * (1.0f / 1024.0f); const float var = qv * (1.0f / 1024.0f) - mean * mean;
                const int row = wid * 16 + i4 * 4 + lane;
                stats[row * 2] = mean; stats[row * 2 + 1] = __builtin_amdgcn_rsqf(fmaxf(var, 0.f) + EPS);
            }
        }
        const int fs = tid >> 2, dseg = (tid & 3) * 32;
        u32x4 raw[4];
#pragma unroll
        for (int i = 0; i < 4; ++i) raw[i] = gld<u32x4>(zc + (size_t)fs * 2048 + 1024 + dseg + i * 8);
#pragma unroll 1
        for (int g = 0; g < 8; ++g) {
            __syncthreads();
            {
                const float mean = stats[fs * 2], rstd = stats[fs * 2 + 1];
#pragma unroll
                for (int i = 0; i < 4; ++i) {
                    const int d = g * 128 + dseg + i * 8;
                    const f32x4 g0 = *(const LAS f32x4*)(lgb + d) * rstd, g1 = *(const LAS f32x4*)(lgb + d + 4) * rstd, b0 = *(const LAS f32x4*)(lgb + 1024 + d), b1 = *(const LAS f32x4*)(lgb + 1024 + d + 4);
                    u32x4 w;
                    w.x = cvt_pk_bf16((bf_lo(raw[i].x) - mean) * g0[0] + b0[0], (bf_hi(raw[i].x) - mean) * g0[1] + b0[1]);
                    w.y = cvt_pk_bf16((bf_lo(raw[i].y) - mean) * g0[2] + b0[2], (bf_hi(raw[i].y) - mean) * g0[3] + b0[3]);
                    w.z = cvt_pk_bf16((bf_lo(raw[i].z) - mean) * g1[0] + b1[0], (bf_hi(raw[i].z) - mean) * g1[1] + b1[1]);
                    w.w = cvt_pk_bf16((bf_lo(raw[i].w) - mean) * g1[2] + b1[2], (bf_hi(raw[i].w) - mean) * g1[3] + b1[3]);
                    *(LAS u32x4*)(vimg + fs * VST + (dseg + i * 8) * 2) = w;
                }
            }
            const int t = 16 * wid + fr;
            bf16x8 wf[4]; u32x2 uu[8];
#pragma unroll
            for (int kk = 0; kk < 4; ++kk) wf[kk] = gld<bf16x8>(Wm + ((size_t)(g * 128 + t)) * 128 + 32 * kk + 8 * fq);
            const size_t ubase = (size_t)chunk * 128 * 2048 + (size_t)t * 2048 + g * 128 + 4 * fq;
#pragma unroll
            for (int nd = 0; nd < 8; ++nd) uu[nd] = gld<u32x2>(Z + ubase + 16 * nd);
            const float bias = gld<float>(bs + g * 128 + t);
            if (g < 7) {
#pragma unroll
                for (int i = 0; i < 4; ++i) raw[i] = gld<u32x4>(zc + (size_t)fs * 2048 + 1024 + (g + 1) * 128 + dseg + i * 8);
            }
            __syncthreads();
            f32x4 acc[8];
#pragma unroll
            for (int nd = 0; nd < 8; ++nd) acc[nd] = (f32x4){0.f, 0.f, 0.f, 0.f};
            const int kkmax = (16 * wid + 15) >> 5;
#pragma unroll
            for (int kk = 0; kk < 4; ++kk) {
                if (kk <= kkmax) {
#pragma unroll
                    for (int nd = 0; nd < 8; ++nd) {
                        LAS uchar* ap = vimg + (32 * kk + 8 * fq + q4) * VST + (16 * nd + 4 * p4) * 2;
                        const bf16x8 vf = cat8(tr_read(ap), tr_read(ap + 4 * VST));
                        acc[nd] = __builtin_amdgcn_mfma_f32_16x16x32_bf16(vf, wf[kk], acc[nd], 0, 0, 0);
                    }
                }
            }
#pragma unroll
            for (int nd = 0; nd < 8; ++nd) {
                u32x2 w; w.x = cvt_pk_bf16(bf_lo(uu[nd].x) * (acc[nd][0] + bias), bf_hi(uu[nd].x) * (acc[nd][1] + bias)); w.y = cvt_pk_bf16(bf_lo(uu[nd].y) * (acc[nd][2] + bias), bf_hi(uu[nd].y) * (acc[nd][3] + bias));
                gst<u32x2>(Zout + ubase + 16 * nd, w);
            }
        }
    }
}

__device__ __forceinline__ void retention_phase(const Ctx cx, LAS uchar* lds, const bf16_t* Q, const bf16_t* Kb, const bf16_t* V, bf16_t* Oout, float* ossq) {
    constexpr int KST = 544, VST = 160, SST = 544;
    LAS uchar* kR = lds;
    LAS uchar* vR = lds + 69632;
    LAS uchar* vS = vR + 20480;
    LAS uchar* ST = vS + 20480;
    const int tid0 = cx.tid, wid = __builtin_amdgcn_readfirstlane(tid0 >> 6);
    const int tw = wid < 4 ? wid : 11 - wid;
    for (int item = cx.bid; item < 256; item += cx.nblk) {
        const int xcd = item & 7, local = item >> 3, pairi = xcd * 4 + (local >> 3);
        const int j = local & 7, h = pairi & 3, b = pairi >> 2;
        const float lg = log2f(1.0f - exp2f(-5.0f - (float)h));
        const float chunk_decay = exp2f(128.0f * lg);
        __syncthreads();
        for (int i = tid0; i < 34816 / 16; i += 512) ((LAS u32x4*)ST)[i] = (u32x4){0u, 0u, 0u, 0u};
        f32x4 accS[2][4];
#pragma unroll
        for (int dl = 0; dl < 2; ++dl)
#pragma unroll
            for (int vt = 0; vt < 4; ++vt) accS[dl][vt] = (f32x4){0.f, 0.f, 0.f, 0.f};
        u32x4 kreg[8]; u32x4 vreg[2]; bf16x8 qn[8];
        const float rowfac = __builtin_amdgcn_exp2f((float)(16 * tw + (tid0 & 15)) * lg), g16i = __builtin_amdgcn_exp2f(-16.0f * lg);
        float colfac[4];
#pragma unroll
        for (int jj = 0; jj < 4; ++jj) colfac[jj] = __builtin_amdgcn_exp2f(-(float)(4 * ((tid0 & 63) >> 4) + jj) * lg);
        {
            const size_t r0 = (size_t)b * SEQ;
            const int lane = tid0 & 63, fr = lane & 15, fq = lane >> 4;
#pragma unroll
            for (int i = 0; i < 8; ++i) { const int idx = tid0 + 512 * i, s = idx >> 5, ch = idx & 31; kreg[i] = gld<u32x4>(Kb + (r0 + s) * DM + h * 256 + ch * 8); }
            { const int s = tid0 >> 2, c16 = (tid0 & 3) * 16; const bf16_t* vp = V + (r0 + s) * 2048 + h * 512 + j * 64 + c16; vreg[0] = gld<u32x4>(vp); vreg[1] = gld<u32x4>(vp + 8); }
#pragma unroll
            for (int kk = 0; kk < 8; ++kk) qn[kk] = gld<bf16x8>(Q + (r0 + 16 * tw + fr) * DM + h * 256 + 32 * kk + 8 * fq);
        }
        for (int c = 0; c < 64; ++c) {
            const size_t r0 = (size_t)b * SEQ + (size_t)c * 128;
            int tid = tid0; asm volatile("" : "+v"(tid));
            const int lane = tid & 63, fr = lane & 15, fq = lane >> 4, q4 = fr >> 2, p4 = fr & 3;
            bf16x8 qf[8];
            __syncthreads();
#pragma unroll
            for (int i = 0; i < 8; ++i) { const int idx = tid + 512 * i, s = idx >> 5, ch = idx & 31; *(LAS u32x4*)(kR + s * KST + ch * 16) = kreg[i]; }
            {
                const int s = tid >> 2, c16 = (tid & 3) * 16; const float sd = __builtin_amdgcn_exp2f((float)(127 - s) * lg);
#pragma unroll
                for (int i = 0; i < 2; ++i) {
                    *(LAS u32x4*)(vR + s * VST + c16 * 2 + i * 16) = vreg[i];
                    u32x4 w;
                    w.x = cvt_pk_bf16(bf_lo(vreg[i].x) * sd, bf_hi(vreg[i].x) * sd); w.y = cvt_pk_bf16(bf_lo(vreg[i].y) * sd, bf_hi(vreg[i].y) * sd);
                    w.z = cvt_pk_bf16(bf_lo(vreg[i].z) * sd, bf_hi(vreg[i].z) * sd); w.w = cvt_pk_bf16(bf_lo(vreg[i].w) * sd, bf_hi(vreg[i].w) * sd);
                    *(LAS u32x4*)(vS + s * VST + c16 * 2 + i * 16) = w;
                }
            }
#pragma unroll
            for (int kk = 0; kk < 8; ++kk) qf[kk] = qn[kk];
            if (c > 0) {
#pragma unroll
                for (int dl = 0; dl < 2; ++dl)
#pragma unroll
                    for (int vt = 0; vt < 4; ++vt) {
                        u32x2 w; w.x = cvt_pk_bf16(accS[dl][vt][0], accS[dl][vt][1]); w.y = cvt_pk_bf16(accS[dl][vt][2], accS[dl][vt][3]);
                        *(LAS u32x2*)(ST + (16 * vt + fr) * SST + (16 * (2 * wid + dl) + 4 * fq) * 2) = w;
                    }
            }
            __syncthreads();
            {
                const size_t rn = (size_t)b * SEQ + (size_t)(c < 63 ? c + 1 : 63) * 128;
#pragma unroll
                for (int i = 0; i < 8; ++i) { const int idx = tid + 512 * i, s = idx >> 5, ch = idx & 31; kreg[i] = gld<u32x4>(Kb + (rn + s) * DM + h * 256 + ch * 8); }
                { const int s = tid >> 2, c16 = (tid & 3) * 16; const bf16_t* vp = V + (rn + s) * 2048 + h * 512 + j * 64 + c16; vreg[0] = gld<u32x4>(vp); vreg[1] = gld<u32x4>(vp + 8); }
            }
            f32x4 accX[4], accI[4];
#pragma unroll
            for (int vt = 0; vt < 4; ++vt) { accX[vt] = (f32x4){0.f, 0.f, 0.f, 0.f}; accI[vt] = (f32x4){0.f, 0.f, 0.f, 0.f}; }
            {
                bf16x8 sa[8];
#pragma unroll
                for (int i = 0; i < 8; ++i) sa[i] = *(const LAS bf16x8*)(ST + (16 * (i & 3) + fr) * SST + (32 * (i >> 2) + 8 * fq) * 2);
#pragma unroll
                for (int r = 0; r < 4; ++r) {
                    __builtin_amdgcn_sched_barrier(0);
                    __builtin_amdgcn_s_setprio(3);
#pragma unroll
                    for (int i = 0; i < 8; ++i) accX[i & 3] = __builtin_amdgcn_mfma_f32_16x16x32_bf16(sa[i], qf[2 * r + (i >> 2)], accX[i & 3], 0, 0, 0);
                    __builtin_amdgcn_s_setprio(0);
                    __builtin_amdgcn_sched_barrier(0);
                    if (r < 3) {
#pragma unroll
                        for (int i = 0; i < 8; ++i) sa[i] = *(const LAS bf16x8*)(ST + (16 * (i & 3) + fr) * SST + (32 * (2 * (r + 1) + (i >> 2)) + 8 * fq) * 2);
                    }
                }
            }
            const int t_in = 16 * tw + fr;
#pragma unroll
            for (int kk2 = 0; kk2 < 4; ++kk2) {
                if (kk2 <= (tw >> 1)) {
                    f32x4 accP0 = (f32x4){0.f, 0.f, 0.f, 0.f}, accP1 = (f32x4){0.f, 0.f, 0.f, 0.f};
#pragma unroll
                    for (int kh = 0; kh < 2; ++kh) {
                        bf16x8 af0[4], af1[4];
#pragma unroll
                        for (int k4 = 0; k4 < 4; ++k4) {
                            af0[k4] = *(const LAS bf16x8*)(kR + (32 * kk2 + fr) * KST + (32 * (4 * kh + k4) + 8 * fq) * 2);
                            af1[k4] = *(const LAS bf16x8*)(kR + (32 * kk2 + 16 + fr) * KST + (32 * (4 * kh + k4) + 8 * fq) * 2);
                        }
                        __builtin_amdgcn_sched_barrier(0);
                        __builtin_amdgcn_s_setprio(3);
#pragma unroll
                        for (int k4 = 0; k4 < 4; ++k4) {
                            accP0 = __builtin_amdgcn_mfma_f32_16x16x32_bf16(af0[k4], qf[4 * kh + k4], accP0, 0, 0, 0);
                            accP1 = __builtin_amdgcn_mfma_f32_16x16x32_bf16(af1[k4], qf[4 * kh + k4], accP1, 0, 0, 0);
                        }
                        __builtin_amdgcn_s_setprio(0);
                    }
                    float pv[8];
                    float rf = rowfac; asm volatile("" : "+v"(rf));
                    const float f0 = rf * __builtin_amdgcn_exp2f(-32.0f * (float)kk2 * lg), f1 = f0 * g16i;
#pragma unroll
                    for (int jj = 0; jj < 4; ++jj) { pv[jj] = accP0[jj] * (f0 * colfac[jj]); pv[4 + jj] = accP1[jj] * (f1 * colfac[jj]); }
                    if (kk2 == (tw >> 1)) {
#pragma unroll
                        for (int jj = 0; jj < 4; ++jj) {
                            const int d0 = t_in - (32 * kk2 + 4 * fq + jj);
                            pv[jj] = d0 >= 0 ? pv[jj] : 0.f; pv[4 + jj] = d0 >= 16 ? pv[4 + jj] : 0.f;
                        }
                    }
                    u32x4 pw; pw.x = cvt_pk_bf16(pv[0], pv[1]); pw.y = cvt_pk_bf16(pv[2], pv[3]); pw.z = cvt_pk_bf16(pv[4], pv[5]); pw.w = cvt_pk_bf16(pv[6], pv[7]);
                    const bf16x8 pf = __builtin_bit_cast(bf16x8, pw);
#pragma unroll
                    for (int vt = 0; vt < 4; ++vt) {
                        LAS uchar* ap = vR + (32 * kk2 + 4 * fq + q4) * VST + (16 * vt + 4 * p4) * 2;
                        const bf16x8 vf = cat8(tr_read(ap), tr_read(ap + 16 * VST));
                        accI[vt] = __builtin_amdgcn_mfma_f32_16x16x32_bf16(vf, pf, accI[vt], 0, 0, 0);
                    }
                }
            }
            {
                const size_t rn = (size_t)b * SEQ + (size_t)(c < 63 ? c + 1 : 63) * 128;
#pragma unroll
                for (int kk = 0; kk < 8; ++kk) qn[kk] = gld<bf16x8>(Q + (rn + 16 * tw + fr) * DM + h * 256 + 32 * kk + 8 * fq);
            }
            {
                const float cd = __builtin_amdgcn_exp2f((float)(t_in + 1) * lg);
                float q = 0.f;
                bf16_t* op = Oout + (r0 + t_in) * 2048 + h * 512 + j * 64 + 4 * fq;
#pragma unroll
                for (int vt = 0; vt < 4; ++vt) {
                    const f32x4 o = accI[vt] + accX[vt] * cd;
                    q += (o[0] * o[0] + o[1] * o[1]) + (o[2] * o[2] + o[3] * o[3]);
                    u32x2 w; w.x = cvt_pk_bf16(o[0], o[1]); w.y = cvt_pk_bf16(o[2], o[3]);
                    gst<u32x2>(op + 16 * vt, w);
                }
                q += __shfl_xor(q, 16); q += __shfl_xor(q, 32);
                if (fq == 0) gst<float>(ossq + (r0 + t_in) * 32 + h * 8 + j, q);
            }
#pragma unroll
            for (int dl = 0; dl < 2; ++dl)
#pragma unroll
                for (int vt = 0; vt < 4; ++vt) accS[dl][vt] = accS[dl][vt] * chunk_decay;
            {
                bf16x8 vf[2][4], kf[2][2];
#define RET_LOAD_STATE_OPS(buf, kk2) do { \
                    _Pragma("unroll") for (int vt = 0; vt < 4; ++vt) { LAS uchar* bp = vS + (32 * (kk2) + 4 * fq + q4) * VST + (16 * vt + 4 * p4) * 2; vf[buf][vt] = cat8(tr_read(bp), tr_read(bp + 16 * VST)); } \
                    _Pragma("unroll") for (int dl = 0; dl < 2; ++dl) { LAS uchar* ap = kR + (32 * (kk2) + 4 * fq + q4) * KST + (16 * (2 * wid + dl) + 4 * p4) * 2; kf[buf][dl] = cat8(tr_read(ap), tr_read(ap + 16 * KST)); } } while (0)
                RET_LOAD_STATE_OPS(0, 0);
#pragma unroll
                for (int kk2 = 0; kk2 < 4; ++kk2) {
                    if (kk2 < 3) RET_LOAD_STATE_OPS((kk2 + 1) & 1, kk2 + 1);
                    __builtin_amdgcn_sched_barrier(0);
                    __builtin_amdgcn_s_setprio(3);
#pragma unroll
                    for (int dl = 0; dl < 2; ++dl)
#pragma unroll
                        for (int vt = 0; vt < 4; ++vt) accS[dl][vt] = __builtin_amdgcn_mfma_f32_16x16x32_bf16(kf[kk2 & 1][dl], vf[kk2 & 1][vt], accS[dl][vt], 0, 0, 0);
                    __builtin_amdgcn_s_setprio(0);
                    __builtin_amdgcn_sched_barrier(0);
                }
#undef RET_LOAD_STATE_OPS
            }
        }
    }
}

#define XB_TMO      128
#define XB_XCNT(j)  (256  + 64 * (j))
#define XB_XSUB(j)  (1280 + 64 * (j))
#define XB_XGEN(j)  (2304 + 64 * (j))
#define XB_TOP      3328
#define XB_TOPGEN   3392
#define XCD_BAR_WORDS 3456
#define XB_SPIN_CAP (1u << 22)
__device__ __forceinline__ unsigned xb_ld(unsigned* p)              { return __hip_atomic_load(p, __ATOMIC_RELAXED, __HIP_MEMORY_SCOPE_AGENT); }
__device__ __forceinline__ unsigned xb_add(unsigned* p, unsigned v) { return __hip_atomic_fetch_add(p, v, __ATOMIC_RELAXED, __HIP_MEMORY_SCOPE_AGENT); }
__device__ __forceinline__ unsigned xb_xcc_id() { return (unsigned)__builtin_amdgcn_s_getreg((3 << 11) | 20) & 0xFu; }
#define XB_SPIN(cond, bar) do { unsigned _sp = 0; while (cond) { __builtin_amdgcn_s_sleep(1); \
    if ((++_sp & 255u) == 0u) { if (xb_ld(&(bar)[XB_TMO])) break; if (_sp > XB_SPIN_CAP) { atomicAdd(&(bar)[XB_TMO], 1u); break; } } } } while (0)
struct XcdBarrier { unsigned* bar; unsigned x; volatile LAS unsigned* st; };
__device__ __forceinline__ XcdBarrier xcd_barrier_post(unsigned* bar, volatile LAS unsigned* st) {
    XcdBarrier b; b.bar = bar; b.x = xb_xcc_id(); b.st = st;
    if (threadIdx.x == 0) (void)xb_add(&bar[XB_XCNT(b.x)], 1u);
    return b;
}
__device__ __forceinline__ void xcd_barrier_complete(unsigned* bar, unsigned x, unsigned& nloc, unsigned& nx) {
    const unsigned G = gridDim.x * gridDim.y * gridDim.z;
    unsigned sum, cnt, mine, sp = 0u;
    for (;;) {
        sum = 0u; cnt = 0u; mine = 0u;
#pragma unroll
        for (unsigned j = 0; j < 16; ++j) { const unsigned c = xb_ld(&bar[XB_XCNT(j)]); sum += c; cnt += (c > 0u) ? 1u : 0u; mine = (j == x) ? c : mine; }
        if (sum == G) break;
        __builtin_amdgcn_s_sleep(1);
        if ((++sp & 255u) == 0u) { if (xb_ld(&bar[XB_TMO])) break; if (sp > XB_SPIN_CAP) { atomicAdd(&bar[XB_TMO], 1u); break; } }
    }
    nloc = mine > 0u ? mine : 1u; nx = cnt > 0u ? cnt : 1u;
}
__device__ __forceinline__ void xcd_barrier(const XcdBarrier& b) {
    asm volatile("s_waitcnt vmcnt(0)" ::: "memory");
    __syncthreads();
    if (threadIdx.x == 0) {
        unsigned* bar = b.bar;
        __builtin_amdgcn_s_waitcnt(0);
        unsigned nloc = b.st[0], nx = b.st[1];
        if (nloc == 0u) { xcd_barrier_complete(bar, b.x, nloc, nx); b.st[0] = nloc; b.st[1] = nx; }
        const unsigned old = xb_add(&bar[XB_XSUB(b.x)], 1u);
        const unsigned gen = old / nloc;
        if (old + 1u == (gen + 1u) * nloc) {
            __builtin_amdgcn_fence(__ATOMIC_RELEASE, "agent");
            asm volatile("s_waitcnt vmcnt(0)" ::: "memory");
            const unsigned og = xb_add(&bar[XB_TOP], 1u);
            const unsigned tg = og / nx;
            if (og + 1u == (tg + 1u) * nx) xb_add(&bar[XB_TOPGEN], 1u);
            else XB_SPIN(xb_ld(&bar[XB_TOPGEN]) == tg, bar);
            __builtin_amdgcn_fence(__ATOMIC_ACQUIRE, "agent");
            xb_add(&bar[XB_XGEN(b.x)], 1u);
            asm volatile("s_waitcnt vmcnt(0)" ::: "memory");
        } else {
            XB_SPIN(xb_ld(&bar[XB_XGEN(b.x)]) == gen, bar);
            __builtin_amdgcn_fence(__ATOMIC_ACQUIRE, "agent");
            asm volatile("s_waitcnt vmcnt(0)" ::: "memory");
        }
    }
    __syncthreads();
}

__global__ void __launch_bounds__(512, 2) mega_fwd(Args a_kernarg) {
#if defined(__HIP_DEVICE_COMPILE__)
    typedef const __attribute__((address_space(4))) Args* KArgs;
    KArgs kap = (KArgs)__builtin_amdgcn_kernarg_segment_ptr();
    const int ph_lo = a_kernarg.ph_lo, ph_hi = a_kernarg.ph_hi;
    extern __shared__ __attribute__((aligned(16))) uchar shm[];
    LAS uchar* lds = (LAS uchar*)shm;
    XcdBarrier bar; bar.bar = nullptr; bar.x = 0; bar.st = (volatile LAS unsigned*)(lds + LDS_MAIN);
    if (ph_hi - ph_lo > 1) {
        if (threadIdx.x < 4) bar.st[threadIdx.x] = 0u;
        __syncthreads();
        bar = xcd_barrier_post((unsigned*)(a_kernarg.ws + WS_BAR), bar.st);
    }
    int probe_rep = 0; (void)probe_rep;
    for (int ph = ph_lo; ph < ph_hi; ++ph) {
        KArgs kapl = kap; asm volatile("" : "+s"(kapl));
        const Args a = *kapl;
        Ctx cx; cx.tid = threadIdx.x; cx.bid = blockIdx.x; cx.nblk = gridDim.x;
        asm volatile("" : "+v"(cx.tid)); asm volatile("" : "+s"(cx.bid)); asm volatile("" : "+s"(cx.nblk));
        uchar* ws = a.ws; asm volatile("" : "+s"(ws));
        float* H = a.out; asm volatile("" : "+s"(H));
        bf16_t* HB = (bf16_t*)(ws + WS_HB); float* ssq = (float*)(ws + WS_SSQ); float* ossq = (float*)(ws + WS_OSSQ);
        bf16_t* BIG = (bf16_t*)(ws + WS_BIG);
        bf16_t* Qb = BIG; bf16_t* Kb = BIG + (size_t)M_TOK * 1024; bf16_t* Vb = BIG + (size_t)M_TOK * 2048;
        StaticOrder S;
        if (ph == 0) { if constexpr (EN(100)) prep_phase(cx, lds, a); }
        else if (ph == NPHASE - 1) { if constexpr (EN(101)) final_phase(cx, a); }
        else {
            const int p = ph - 1, pair = p / 11, q = p % 11;
            const int L = 2 * pair + (q >= 5 ? 1 : 0);
            switch (q) {
            case 0: if constexpr (EN(0)) {
                Gemm g{HB, (const bf16_t*)(ws + WS_SGU_IN) + (size_t)pair * 2048 * 1024, M_TOK, 2048, 1024, 1024, 1024};
                S.init(M_TOK, 2048, cx.nblk, cx.bid, (0x295 >> q) & 1); EpiGelu E{BIG, ssq}; gemm_phase<EpiGelu>(cx, lds, g, S, E); } break;
            case 1:
                if constexpr (EN(1)) sgu_mix_phase(cx, lds, BIG,
#if PROBE_Q == 1
                    (!probe_rep) ? (bf16_t*)(ws + WS_END) :
#endif
                    BIG, (const bf16_t*)(ws + WS_WSM) + (size_t)pair * 8 * 128 * 128, a.sgu_b_s + pair * 8 * 128, a.sgu_ln_g + pair * 1024, a.sgu_ln_b + pair * 1024);
                break;
            case 2: case 4: case 8: case 10: if constexpr (EN(2)) {
                Gemm g;
                if (q == 2) g = Gemm{BIG, (const bf16_t*)(ws + WS_SGU_OUT) + (size_t)pair * 1024 * 1024, M_TOK, 1024, 1024, 2048, 1024};
                else if (q == 8) g = Gemm{Vb, (const bf16_t*)(ws + WS_RET_OUT) + (size_t)pair * 1024 * 2048, M_TOK, 1024, 2048, 2048, 2048};
                else g = Gemm{BIG, (const bf16_t*)(ws + WS_DOWN) + (size_t)L * 1024 * FF, M_TOK, 1024, FF, FF, FF};
                S.init(M_TOK, 1024, cx.nblk, cx.bid, (0x295 >> q) & 1); EpiRes E{HB, HB, ssq};
#if defined(PROBE_RES)
                if (!probe_rep && PROBE_MATCH(q)) E.HBout = (bf16_t*)(ws + WS_END);
#endif
                gemm_phase<EpiRes>(cx, lds, g, S, E); } break;
            case 3: case 9: if constexpr (EN(3)) {
                Gemm g{HB, (const bf16_t*)(ws + WS_GU) + (size_t)L * 5632 * 1024, M_TOK, 5632, 1024, 1024, 1024};
                S.init(M_TOK, 5632, cx.nblk, cx.bid, (0x295 >> q) & 1); EpiSwiglu E{BIG, ssq}; gemm_phase<EpiSwiglu>(cx, lds, g, S, E); } break;
            case 5: if constexpr (EN(5)) {
                Gemm g{HB, (const bf16_t*)(ws + WS_RET_IN) + (size_t)pair * 6144 * 1024, M_TOK, 4096, 1024, 1024, 1024};
                S.init(M_TOK, 4096, cx.nblk, cx.bid, (0x295 >> q) & 1); EpiQKV E{Qb, Kb, Vb, ssq, a.pos}; gemm_phase<EpiQKV>(cx, lds, g, S, E); } break;
            case 6:
                if constexpr (EN(6)) {
#if PROBE_Q == 6
                    if (!probe_rep) retention_phase(cx, lds, Qb, Kb, Vb, (bf16_t*)(ws + WS_END), ossq); else
#endif
                    retention_phase(cx, lds, Qb, Kb, Vb, Vb, ossq); }
                break;
            case 7: if constexpr (EN(7)) {
                Gemm g{HB, (const bf16_t*)(ws + WS_RET_IN) + (size_t)pair * 6144 * 1024 + (size_t)4096 * 1024, M_TOK, 2048, 1024, 1024, 1024};
                S.init(M_TOK, 2048, cx.nblk, cx.bid, (0x295 >> q) & 1); EpiGate E{Vb, ssq, ossq, a.ret_gn_g + pair * 2048}; gemm_phase<EpiGate>(cx, lds, g, S, E); } break;
            default: break;
            }
        }
        if (ph + 1 < ph_hi) {
            if (ph < 0) { __threadfence(); cg::this_grid().sync(); }
            else xcd_barrier(bar);
        }
#if defined(PROBE_MATCH)
        {
            const int pq = (ph == 0) ? 100 : (ph == NPHASE - 1) ? 101 : ((ph - 1) % 11);
            if (PROBE_MATCH(pq) && !probe_rep) { probe_rep = 1; --ph; } else probe_rep = 0;
        }
#endif
    }
#endif
}

extern "C" void kernel_launch(void* const* d_in, const int* in_sizes, int n_in, void* d_out, int out_size, void* d_ws, size_t ws_size, hipStream_t stream) {
    static int grid = 0;
    if (grid == 0) {
        if (n_in != 16 || out_size != M_TOK * DM || ws_size < WS_END) { fprintf(stderr, "kernel_launch: unexpected shapes (n_in %d out %d ws %zu)\n", n_in, out_size, ws_size); grid = -1; return; }
        int dev = 0, cus = 0, per_cu = 0;
        hipGetDevice(&dev); hipDeviceGetAttribute(&cus, hipDeviceAttributeMultiprocessorCount, dev);
        if (hipFuncSetAttribute((const void*)mega_fwd, hipFuncAttributeMaxDynamicSharedMemorySize, LDS_BYTES) != hipSuccess) { fprintf(stderr, "kernel_launch: hipFuncSetAttribute failed\n"); grid = -1; return; }
        if (hipOccupancyMaxActiveBlocksPerMultiprocessor(&per_cu, (const void*)mega_fwd, 512, LDS_BYTES) != hipSuccess || per_cu < 1) per_cu = 1;
        (void)hipGetLastError();
        grid = cus * per_cu;
    }
    if (grid < 0) return;
    Args a{};
    a.x = (const float*)d_in[0]; a.pos = (const int*)d_in[1]; a.mix_g = (const float*)d_in[2]; a.ffn_g = (const float*)d_in[3]; a.fin_g = (const float*)d_in[4];
    a.sgu_w_in = (const float*)d_in[5]; a.sgu_w_s = (const float*)d_in[6]; a.sgu_b_s = (const float*)d_in[7]; a.sgu_ln_g = (const float*)d_in[8]; a.sgu_ln_b = (const float*)d_in[9];
    a.sgu_w_out = (const float*)d_in[10]; a.ret_w_in = (const float*)d_in[11]; a.ret_gn_g = (const float*)d_in[12]; a.ret_w_out = (const float*)d_in[13];
    a.ffn_w_gu = (const float*)d_in[14]; a.ffn_w_down = (const float*)d_in[15];
    a.out = (float*)d_out; a.ws = (uchar*)d_ws;
#if MODE_ONE_LAUNCH
    a.ph_lo = 0; a.ph_hi = NPHASE;
    if (hipMemsetAsync((uchar*)d_ws + WS_BAR, 0, 16384, stream) != hipSuccess) { fprintf(stderr, "kernel_launch: memset of the barrier words failed\n"); return; }
    void* args[] = {&a};
    hipError_t e = hipLaunchCooperativeKernel((const void*)mega_fwd, dim3(grid), dim3(512), args, LDS_BYTES, stream);
    if (e != hipSuccess) fprintf(stderr, "cooperative launch failed: %s (grid %d)\n", hipGetErrorString(e), grid);
#else
    for (int ph = 0; ph < NPHASE; ++ph) {
        a.ph_lo = ph; a.ph_hi = ph + 1;
        hipLaunchKernelGGL(mega_fwd, dim3(grid), dim3(512), LDS_BYTES, stream, a);
    }
#endif
}
```
